# Optimizing an MI355X kernel written in HIP

```python
import math
import jax
import jax.numpy as jnp
from jax import lax
import numpy as np

D_MODEL = 1024
BATCH = 8
SEQ = 2048
DEPTH = 2

GROUP_WIDTH = D_MODEL // 4
HEAD_DIM = 64
N_HEADS_A = GROUP_WIDTH // HEAD_DIM
DIFF_DH = HEAD_DIM // 2
N_HEADS_B = GROUP_WIDTH // HEAD_DIM
CONV_CH = GROUP_WIDTH
CONV_GROUPS = 4
CONV_K = 31
N_HEADS_D = GROUP_WIDTH // HEAD_DIM
DILATED_CFG = ((128, 1), (512, 4), (2048, 16))
GRID_W = 64
NA_KH_MAX = 8
NA_KW = 16
ROPE_THETA = 10000.0
Q_BLOCK = 128
N_GROUPS = 4
EXPERTS_PER_GROUP = 8
N_EXPERTS = N_GROUPS * EXPERTS_PER_GROUP
TOP_K_INNER = 2
D_EXPERT = D_MODEL // 2
MOE_BLOCK = 256
EPS = 1e-6
NEG_INF = -1e30

W_A = 3 * N_HEADS_A * HEAD_DIM
W_B = 3 * N_HEADS_B * HEAD_DIM
W_C = 2 * CONV_CH
W_D = 3 * N_HEADS_D * HEAD_DIM
P_IN = W_A + W_B + W_C + W_D

kernel_name = "hybrid_parallel_mixer_hmoe_block"

F32 = jnp.float32


def rms_norm(x, g):
    xf = x.astype(F32)
    y = xf * lax.rsqrt(jnp.mean(xf * xf, axis=-1, keepdims=True) + EPS)
    return (y * g.astype(F32)).astype(x.dtype)


def rotary(x):
    s, d = x.shape[1], x.shape[-1]
    inv = ROPE_THETA ** (-jnp.arange(0, d, 2, dtype=F32) / d)
    ang = jnp.arange(s, dtype=F32)[:, None] * inv[None, :]
    shp = (1, s) + (1,) * (x.ndim - 3) + (d // 2,)
    cos, sin = jnp.cos(ang).reshape(shp), jnp.sin(ang).reshape(shp)
    xf = x.astype(F32)
    x1, x2 = xf[..., : d // 2], xf[..., d // 2:]
    return jnp.concatenate([x1 * cos - x2 * sin, x2 * cos + x1 * sin], axis=-1).astype(x.dtype)


def diff_attention(q, k, v, lam_params, subln_g, layer_idx):
    b, s, h = q.shape[:3]
    lam_init = 0.8 - 0.6 * math.exp(-0.3 * layer_idx)
    lp = lam_params.astype(F32)
    lam = jnp.exp(jnp.sum(lp[0] * lp[1])) - jnp.exp(jnp.sum(lp[2] * lp[3])) + lam_init
    q, k = rotary(q), rotary(k)
    scale = DIFF_DH ** -0.5
    nqb = s // Q_BLOCK
    qb = jnp.moveaxis(q.reshape(b, nqb, Q_BLOCK, h, 2, DIFF_DH), 1, 0)

    def block(qi):
        sc = jnp.einsum('bqhce,bkhce->bhcqk', qi, k).astype(F32) * scale
        p = jax.nn.softmax(sc, axis=-1)
        a = p[:, :, 0] - lam * p[:, :, 1]
        return jnp.einsum('bhqk,bkhe->bqhe', a.astype(v.dtype), v)

    o = jnp.moveaxis(lax.map(block, qb), 0, 1).reshape(b, s, h, 2 * DIFF_DH)
    o = rms_norm(o, subln_g) * (1.0 - lam_init)
    return o.reshape(b, s, h * 2 * DIFF_DH)


def neighborhood_attention(q, k, v, rpb):
    b, s, h, e = q.shape
    rows = s // GRID_W
    kh = min(NA_KH_MAX, rows)
    kw = NA_KW
    qg = q.reshape(b, rows, GRID_W, h, e)
    kg = k.reshape(b, rows, GRID_W, h, e)
    vg = v.reshape(b, rows, GRID_W, h, e)
    ri = jnp.arange(rows)
    ci = jnp.arange(GRID_W)
    row_start = jnp.clip(ri - kh // 2, 0, rows - kh)
    row_idx = row_start[:, None] + jnp.arange(kh)[None, :]
    col_start = jnp.clip(ci - kw // 2, 0, GRID_W - kw)
    col_ok = (ci[None, :] >= col_start[:, None]) & (ci[None, :] < col_start[:, None] + kw)
    kr = kg[:, row_idx]
    vr = vg[:, row_idx]
    dr = row_idx - ri[:, None] + NA_KH_MAX - 1
    dc = jnp.clip(ci[None, :] - ci[:, None], -(kw - 1), kw - 1) + kw - 1
    bias = rpb.astype(F32)[:, dr[:, None, :, None], dc[None, :, None, :]]
    sc = jnp.einsum('bijhe,biawhe->bhijaw', qg, kr).astype(F32) * (e ** -0.5) + bias[None]
    sc = jnp.where(col_ok[:, None, :], sc, NEG_INF)
    p = jax.nn.softmax(sc.reshape(b, h, rows, GRID_W, kh * GRID_W), axis=-1).reshape(sc.shape)
    o = jnp.einsum('bhijaw,biawhe->bijhe', p.astype(v.dtype), vr)
    return o.reshape(b, s, h * e)


def conformer_conv(u, w_dw, b_dw, g_n, b_n):
    a, g = jnp.split(u, 2, axis=-1)
    z = a * jax.nn.sigmoid(g)
    z = lax.conv_general_dilated(
        z, w_dw[:, None, :].astype(z.dtype), window_strides=(1,),
        padding=[(CONV_K // 2, CONV_K // 2)], dimension_numbers=('NWC', 'WIO', 'NWC'),
        feature_group_count=CONV_CH) + b_dw.astype(z.dtype)
    b, s, ch = z.shape
    zf = z.astype(F32).reshape(b, s, CONV_GROUPS, ch // CONV_GROUPS)
    mu = jnp.mean(zf, axis=-1, keepdims=True)
    var = jnp.mean(jnp.square(zf - mu), axis=-1, keepdims=True)
    zn = ((zf - mu) * lax.rsqrt(var + EPS)).reshape(b, s, ch) * g_n.astype(F32) + b_n.astype(F32)
    return jax.nn.silu(zn).astype(u.dtype)


def dilated_branch(q, k, v, dilation, n_side):
    b, s, h, e = q.shape
    L = s // dilation
    blk = n_side
    nb = -(-L // blk)
    Lp = nb * blk

    def split(t):
        return t.reshape(b, L, dilation, h, e).transpose(0, 2, 1, 3, 4).reshape(b * dilation, L, h, e)

    qs, ks, vs = split(q), split(k), split(v)
    qb = jnp.pad(qs, ((0, 0), (0, Lp - L), (0, 0), (0, 0))).reshape(-1, nb, blk, h, e)

    def band(t):
        tp = jnp.pad(t, ((0, 0), (blk, Lp - L + blk), (0, 0), (0, 0))).reshape(-1, nb + 2, blk, h, e)
        return jnp.concatenate([tp[:, :-2], tp[:, 1:-1], tp[:, 2:]], axis=2)

    kb, vb = band(ks), band(vs)
    qpos = jnp.arange(nb)[:, None] * blk + jnp.arange(blk)[None, :]
    kpos = jnp.arange(nb)[:, None] * blk - blk + jnp.arange(3 * blk)[None, :]
    rel = kpos[:, None, :] - qpos[:, :, None]
    ok = (jnp.abs(rel) <= n_side) & (kpos[:, None, :] >= 0) & (kpos[:, None, :] < L)
    sc = jnp.einsum('ncqhe,nckhe->nhcqk', qb, kb).astype(F32) * (e ** -0.5)
    sc = jnp.where(ok, sc, NEG_INF)
    m = jnp.max(sc, axis=-1, keepdims=True)
    pe = jnp.exp(sc - m)
    l = jnp.sum(pe, axis=-1, keepdims=True)
    o = jnp.einsum('nhcqk,nckhe->ncqhe', (pe / l).astype(v.dtype), vb)
    lse = (m + jnp.log(l))[..., 0]

    def merge(t):
        t = t.reshape((b, dilation, Lp) + t.shape[2:])[:, :, :L]
        t = jnp.swapaxes(t, 1, 2)
        return t.reshape((b, s) + t.shape[3:])

    o = merge(o.reshape(b * dilation, Lp, h, e))
    lse = merge(jnp.transpose(lse, (0, 2, 3, 1)).reshape(b * dilation, Lp, h))
    return o, lse


def dilated_attention(q, k, v):
    b, s, h, e = q.shape
    q, k = rotary(q), rotary(k)
    outs, lses = [], []
    for window, dil in DILATED_CFG:
        o, lse = dilated_branch(q, k, v, dil, window // (2 * dil))
        outs.append(o)
        lses.append(lse)
    wts = jax.nn.softmax(jnp.stack(lses, axis=0), axis=0)
    o = jnp.einsum('gbsh,gbshe->bshe', wts, jnp.stack(outs, axis=0).astype(F32))
    return o.astype(v.dtype).reshape(b, s, h * e)


def expert_dispatch(xt, eid, gates, w_gate, w_up, w_down):
    T, d = xt.shape
    A = T * TOP_K_INNER
    flat_e = eid.reshape(-1)
    flat_tok = jnp.repeat(jnp.arange(T), TOP_K_INNER, total_repeat_length=A)
    flat_g = gates.reshape(-1)
    order = jnp.argsort(flat_e)
    se, stok, sg = flat_e[order], flat_tok[order], flat_g[order]
    counts = jnp.bincount(flat_e, length=N_EXPERTS)
    seg_start = jnp.cumsum(counts) - counts
    padded = (counts + MOE_BLOCK - 1) // MOE_BLOCK * MOE_BLOCK
    pad_end = jnp.cumsum(padded)
    pad_start = pad_end - padded
    dest = pad_start[se] + jnp.arange(A) - seg_start[se]
    nblk = A // MOE_BLOCK + N_EXPERTS
    buf_tok = jnp.zeros((nblk * MOE_BLOCK,), jnp.int32).at[dest].set(stok.astype(jnp.int32))
    blk_e = jnp.minimum(jnp.searchsorted(pad_end, jnp.arange(nblk) * MOE_BLOCK, side='right'), N_EXPERTS - 1)
    xb = xt[buf_tok].reshape(nblk, MOE_BLOCK, d)

    def run(args):
        xe, e_i = args
        hdn = jax.nn.silu(xe @ w_gate[e_i]) * (xe @ w_up[e_i])
        return hdn @ w_down[e_i]

    yb = lax.map(run, (xb, blk_e)).reshape(nblk * MOE_BLOCK, d)
    contrib = yb[dest].astype(F32) * sg[:, None]
    return jnp.zeros((T, d), F32).at[stok].add(contrib).astype(xt.dtype)


def hier_moe(h, w_rg, w_re, w_gate, w_up, w_down):
    b, s, d = h.shape
    xt = h.reshape(-1, d)
    lg = (xt @ w_rg).astype(F32)
    pg = jax.nn.softmax(lg, axis=-1)
    grp = jnp.argmax(lg, axis=-1)
    p_grp = jnp.take_along_axis(pg, grp[:, None], axis=-1)
    le = jnp.einsum('td,gde->tge', xt, w_re).astype(F32)
    le = jnp.take_along_axis(le, grp[:, None, None], axis=1)[:, 0]
    top_v, top_i = lax.top_k(le, TOP_K_INNER)
    gates = p_grp * jax.nn.softmax(top_v, axis=-1)
    eid = grp[:, None] * EXPERTS_PER_GROUP + top_i
    return expert_dispatch(xt, eid, gates, w_gate, w_up, w_down).reshape(b, s, d)


def setup_inputs(seed: int = 0) -> dict:
    key = jax.random.key(seed)
    ks = jax.random.split(key, 24)
    L, D = DEPTH, D_MODEL
    nrm = lambda k, shp, sc: jax.random.normal(k, shp, F32) * sc
    return {
        "x": nrm(ks[0], (BATCH, SEQ, D), 1.0),
        "c": nrm(ks[1], (BATCH, D), 1.0),
        "w_ada": nrm(ks[2], (L, D, 6 * D), 0.5 * D ** -0.5),
        "b_ada": nrm(ks[3], (L, 6 * D), 0.01),
        "g_norm1": 1.0 + nrm(ks[4], (L, D), 0.05),
        "g_norm2": 1.0 + nrm(ks[5], (L, D), 0.05),
        "w_in": nrm(ks[6], (L, D, P_IN), D ** -0.5),
        "diff_lambda": nrm(ks[7], (L, 4, DIFF_DH), 0.1),
        "diff_subln": 1.0 + nrm(ks[8], (L, 2 * DIFF_DH), 0.05),
        "na_rpb": nrm(ks[9], (L, N_HEADS_B, 2 * NA_KH_MAX - 1, 2 * NA_KW - 1), 0.05),
        "conv_dw": nrm(ks[10], (L, CONV_K, CONV_CH), CONV_K ** -0.5),
        "conv_b": nrm(ks[11], (L, CONV_CH), 0.01),
        "conv_norm_g": 1.0 + nrm(ks[12], (L, CONV_CH), 0.05),
        "conv_norm_b": nrm(ks[13], (L, CONV_CH), 0.01),
        "w_out": nrm(ks[14], (L, D, D), D ** -0.5),
        "w_router_group": nrm(ks[15], (L, D, N_GROUPS), D ** -0.5),
        "w_router_expert": nrm(ks[16], (L, N_GROUPS, D, EXPERTS_PER_GROUP), D ** -0.5),
        "w_exp_gate": nrm(ks[17], (L, N_EXPERTS, D, D_EXPERT), D ** -0.5),
        "w_exp_up": nrm(ks[18], (L, N_EXPERTS, D, D_EXPERT), D ** -0.5),
        "w_exp_down": nrm(ks[19], (L, N_EXPERTS, D_EXPERT, D), D_EXPERT ** -0.5),
        "g_final": 1.0 + nrm(ks[20], (D,), 0.05),
    }


def reference(x, c, w_ada, b_ada, g_norm1, g_norm2, w_in, diff_lambda, diff_subln, na_rpb,
              conv_dw, conv_b, conv_norm_g, conv_norm_b, w_out, w_router_group, w_router_expert,
              w_exp_gate, w_exp_up, w_exp_down, g_final):
    b, s, d = x.shape
    ca = jax.nn.silu(c)
    for l in range(DEPTH):
        mod = ca @ w_ada[l] + b_ada[l]
        sh1, sc1, gt1, sh2, sc2, gt2 = [m[:, None, :] for m in jnp.split(mod, 6, axis=-1)]
        h = rms_norm(x, g_norm1[l]) * (1.0 + sc1) + sh1
        proj = h @ w_in[l]
        pa, pb, pc, pd = jnp.split(proj, [W_A, W_A + W_B, W_A + W_B + W_C], axis=-1)
        qa, ka, va = jnp.split(pa, 3, axis=-1)
        ya = diff_attention(qa.reshape(b, s, N_HEADS_A, 2, DIFF_DH),
                            ka.reshape(b, s, N_HEADS_A, 2, DIFF_DH),
                            va.reshape(b, s, N_HEADS_A, HEAD_DIM),
                            diff_lambda[l], diff_subln[l], l)
        qb_, kb_, vb_ = [t.reshape(b, s, N_HEADS_B, HEAD_DIM) for t in jnp.split(pb, 3, axis=-1)]
        yb = neighborhood_attention(qb_, kb_, vb_, na_rpb[l])
        yc = conformer_conv(pc, conv_dw[l], conv_b[l], conv_norm_g[l], conv_norm_b[l])
        qd, kd, vd = [t.reshape(b, s, N_HEADS_D, HEAD_DIM) for t in jnp.split(pd, 3, axis=-1)]
        yd = dilated_attention(qd, kd, vd)
        mix = jnp.concatenate([ya, yb, yc, yd], axis=-1) @ w_out[l]
        x = x + gt1 * mix
        h2 = rms_norm(x, g_norm2[l]) * (1.0 + sc2) + sh2
        x = x + gt2 * hier_moe(h2, w_router_group[l], w_router_expert[l],
                               w_exp_gate[l], w_exp_up[l], w_exp_down[l])
    return rms_norm(x, g_final)
```

```cpp
#include <hip/hip_runtime.h>
#include <cstdio>
#include <cstdint>

constexpr int BATCH = 8, SEQ = 2048, DM = 1024, T = BATCH * SEQ, DEPTH = 2;
constexpr int P_IN = 2816, NE = 32, DE = 512, NSLOT = (T * 2 / 256 + NE) * 256;
constexpr float EPS = 1e-6f, LOG2E = 1.4426950408889634f;
constexpr size_t TENS = (size_t)BATCH * 4 * SEQ * 64;

constexpr size_t MiB = 1u << 20;
constexpr size_t OFF_CTL = 0, CTL_BYTES = 64 * 1024;
constexpr size_t OFF_MOD = 64 * 1024;
constexpr size_t OFF_ROT = 512 * 1024;
constexpr size_t OFF_LAM = 1280 * 1024;
constexpr size_t OFF_ROUTE = 1536 * 1024;
constexpr size_t OFF_W = 2 * MiB;
constexpr size_t OFF_PRAW = 18 * MiB;
constexpr size_t OFF_X1 = 210 * MiB, OFF_X2 = 274 * MiB, OFF_H = 338 * MiB, OFF_P = 370 * MiB, OFF_C = 450 * MiB, WS_END = 490 * MiB;
constexpr int CW_CNT = 4096;

typedef unsigned short bf16_t;
typedef float f32x4 __attribute__((ext_vector_type(4)));
typedef unsigned u32x4 __attribute__((ext_vector_type(4)));
typedef unsigned u32x2 __attribute__((ext_vector_type(2)));

__device__ __forceinline__ unsigned f2bf(float f) { unsigned u = __builtin_bit_cast(unsigned, f); return (u + 0x7fffu + ((u >> 16) & 1u)) >> 16; }
__device__ __forceinline__ unsigned pk2(float lo, float hi) { return f2bf(lo) | (f2bf(hi) << 16); }
__device__ __forceinline__ float bf2f(unsigned short h) { return __builtin_bit_cast(float, (unsigned)h << 16); }
__device__ __forceinline__ float bflo(unsigned w) { return __builtin_bit_cast(float, w << 16); }
__device__ __forceinline__ float bfhi(unsigned w) { return __builtin_bit_cast(float, w & 0xffff0000u); }
__device__ __forceinline__ float wave_sum(float v) {
#pragma unroll
    for (int o = 1; o < 64; o <<= 1) v += __shfl_xor(v, o);
    return v;
}
__device__ __forceinline__ float silu_f(float v) { return v / (1.f + __expf(-v)); }

__global__ void k_tables(float* rot, float* lamv, const float* diff_lambda) {
    const int pos = blockIdx.x, i = threadIdx.x;
    float* cos64 = rot; float* sin64 = rot + 2048 * 32; float* cos32 = rot + 2 * 2048 * 32; float* sin32 = cos32 + 2048 * 16;
    if (i < 32) { const double inv = pow(10000.0, -(double)i / 32.0), a = (double)pos * inv; cos64[pos * 32 + i] = (float)cos(a); sin64[pos * 32 + i] = (float)sin(a); }
    if (i < 16) { const double inv = pow(10000.0, -(double)i / 16.0), a = (double)pos * inv; cos32[pos * 16 + i] = (float)cos(a); sin32[pos * 16 + i] = (float)sin(a); }
    if (pos == 0 && i < DEPTH) {
        const float* lp = diff_lambda + i * 4 * 32; float s01 = 0.f, s23 = 0.f;
        for (int e = 0; e < 32; ++e) { s01 += lp[e] * lp[32 + e]; s23 += lp[64 + e] * lp[96 + e]; }
        const float lam_init = 0.8f - 0.6f * expf(-0.3f * (float)i);
        lamv[2 * i] = expf(s01) - expf(s23) + lam_init; lamv[2 * i + 1] = 1.f - lam_init;
    }
}
__global__ void k_adaln(const float* c, const float* w_ada, const float* b_ada, float* mod) {
    const int n = blockIdx.x * 256 + threadIdx.x, b = blockIdx.y, l = blockIdx.z;
    const float* w = w_ada + (size_t)l * DM * 6144 + n; const float* cb = c + b * DM;
    float acc = b_ada[l * 6144 + n];
    for (int d = 0; d < DM; ++d) acc += silu_f(cb[d]) * w[(size_t)d * 6144];
    mod[((size_t)l * BATCH + b) * 6144 + n] = acc;
}
__device__ __forceinline__ void load_row(const float* xr, int lane, f32x4 (&v)[4]) {
#pragma unroll
    for (int j = 0; j < 4; ++j) v[j] = *(const f32x4*)(xr + 256 * j + 4 * lane);
}
__device__ __forceinline__ void norm_mod_row(f32x4 (&v)[4], const float* g, const float* sc, const float* sh, int lane) {
    float s = 0.f;
#pragma unroll
    for (int j = 0; j < 4; ++j) s += (v[j].x * v[j].x + v[j].y * v[j].y) + (v[j].z * v[j].z + v[j].w * v[j].w);
    const float rstd = 1.0f / sqrtf(wave_sum(s) * (1.f / DM) + EPS);
#pragma unroll
    for (int j = 0; j < 4; ++j) {
        const f32x4 gg = *(const f32x4*)(g + 256 * j + 4 * lane);
        f32x4 y = v[j] * rstd * gg;
        if (sc) { const f32x4 a = *(const f32x4*)(sc + 256 * j + 4 * lane), b = *(const f32x4*)(sh + 256 * j + 4 * lane); y = y * (1.f + a) + b; }
        v[j] = y;
    }
}
__device__ __forceinline__ void store_row_bf16(bf16_t* o, int lane, const f32x4 (&v)[4]) {
#pragma unroll
    for (int j = 0; j < 4; ++j) { u32x2 w; w.x = pk2(v[j].x, v[j].y); w.y = pk2(v[j].z, v[j].w); *(u32x2*)(o + 256 * j + 4 * lane) = w; }
}
__device__ __forceinline__ void store_row_f32(float* o, int lane, const f32x4 (&v)[4]) {
#pragma unroll
    for (int j = 0; j < 4; ++j) *(f32x4*)(o + 256 * j + 4 * lane) = v[j];
}
__global__ __launch_bounds__(256) void k_norm(const float* x, const float* g, const float* modl, bf16_t* h) {
    const int lane = threadIdx.x & 63, row = blockIdx.x * 4 + (threadIdx.x >> 6), b = row / SEQ;
    f32x4 v[4]; load_row(x + (size_t)row * DM, lane, v);
    const float* m = modl + (size_t)b * 6144;
    norm_mod_row(v, g, m + 1024, m, lane);
    store_row_bf16(h + (size_t)row * DM, lane, v);
}

template <int NB, class BSel, class Epi>
__global__ __launch_bounds__(256) void k_gemm_naive(const bf16_t* A, long long K_, BSel bsel, Epi epi) {
    const int K = (int)K_;
    __shared__ float As[16][68];
    __shared__ float Bs[NB][16][64];
    const int tid = threadIdx.x, tx = tid & 15, ty = tid >> 4, rt = blockIdx.y, ct = blockIdx.x;
    const float* Bp[NB]; int ldb;
    if (!bsel(rt, Bp, ldb)) return;
    float acc[NB][4][4];
#pragma unroll
    for (int q = 0; q < NB; ++q)
#pragma unroll
        for (int i = 0; i < 4; ++i)
#pragma unroll
            for (int j = 0; j < 4; ++j) acc[q][i][j] = 0.f;
    const int ar = tid >> 2, ak = (tid & 3) * 4, bk = tid >> 4, bn = (tid & 15) * 4;
    for (int k0 = 0; k0 < K; k0 += 16) {
        const u32x2 aw = *(const u32x2*)(A + (size_t)(rt * 64 + ar) * K + k0 + ak);
        As[ak + 0][ar] = bflo(aw.x); As[ak + 1][ar] = bfhi(aw.x); As[ak + 2][ar] = bflo(aw.y); As[ak + 3][ar] = bfhi(aw.y);
#pragma unroll
        for (int q = 0; q < NB; ++q) *(f32x4*)&Bs[q][bk][bn] = *(const f32x4*)(Bp[q] + (size_t)(k0 + bk) * ldb + ct * 64 + bn);
        __syncthreads();
#pragma unroll
        for (int k = 0; k < 16; ++k) {
            const f32x4 a = *(const f32x4*)&As[k][ty * 4];
#pragma unroll
            for (int q = 0; q < NB; ++q) { const f32x4 b = *(const f32x4*)&Bs[q][k][tx * 4];
#pragma unroll
                for (int i = 0; i < 4; ++i)
#pragma unroll
                    for (int j = 0; j < 4; ++j) acc[q][i][j] += a[i] * b[j]; }
        }
        __syncthreads();
    }
#pragma unroll
    for (int i = 0; i < 4; ++i)
#pragma unroll
        for (int j = 0; j < 4; ++j) { float v[NB];
#pragma unroll
            for (int q = 0; q < NB; ++q) v[q] = acc[q][i][j];
            epi(rt * 64 + ty * 4 + i, ct * 64 + tx * 4 + j, v); }
}
struct BSelPlain { const float* B; int ldb; int pad; __device__ bool operator()(int, const float* (&Bp)[1], int& l) const { Bp[0] = B; l = ldb; return true; } };
struct EpiRaw { float* C; int ldc; int pad; __device__ void operator()(int r, int c, const float (&v)[1]) const { C[(size_t)r * ldc + c] = v[0]; } };
struct EpiResid { const float* xin; const float* modl; float* out; __device__ void operator()(int r, int c, const float (&v)[1]) const {
    const int b = r / SEQ; out[(size_t)r * DM + c] = xin[(size_t)r * DM + c] + modl[(size_t)b * 6144 + 2048 + c] * v[0]; } };
__device__ __forceinline__ int expert_of_row(const unsigned* cnt, int row, int& total) {
    int start = 0, e_found = -1;
    for (int e = 0; e < NE; ++e) { const int pad = ((int)cnt[e] + 255) / 256 * 256; if (row >= start && row < start + pad) e_found = e; start += pad; }
    total = start; return e_found;
}
struct BSelGU { const unsigned* cnt; const float* wg; const float* wu; __device__ bool operator()(int rt, const float* (&Bp)[2], int& l) const {
    int total; const int e = expert_of_row(cnt, rt * 64, total); if (e < 0) return false;
    Bp[0] = wg + (size_t)e * DM * DE; Bp[1] = wu + (size_t)e * DM * DE; l = DE; return true; } };
struct EpiGU { bf16_t* hdn; __device__ void operator()(int r, int c, const float (&v)[2]) const { hdn[(size_t)r * DE + c] = (bf16_t)f2bf(silu_f(v[0]) * v[1]); } };
struct BSelDN { const unsigned* cnt; const float* wd; __device__ bool operator()(int rt, const float* (&Bp)[1], int& l) const {
    int total; const int e = expert_of_row(cnt, rt * 64, total); if (e < 0) return false;
    Bp[0] = wd + (size_t)e * DE * DM; l = DM; return true; } };
struct EpiY { bf16_t* y; __device__ void operator()(int r, int c, const float (&v)[1]) const { y[(size_t)r * DM + c] = (bf16_t)f2bf(v[0]); } };

__global__ __launch_bounds__(256) void k_postproj(const float* raw, const float* rot, bf16_t* P) {
    const int t = blockIdx.x, pn = blockIdx.y, pc = threadIdx.x, b = t / SEQ, s = t % SEQ;
    const float* r = raw + (size_t)t * P_IN;
    const float* cos64 = rot; const float* sin64 = rot + 2048 * 32; const float* cos32 = rot + 2 * 2048 * 32; const float* sin32 = cos32 + 2048 * 16;
    const int h = pc >> 6, e = pc & 63;
    float val; int tens;
    if (pn == 0 || pn == 1) {
        const int cmap = e >> 5, p = e & 31, i = p >> 1, odd = p & 1, base = pn * 256 + h * 64 + cmap * 32;
        const float x1 = r[base + i], x2 = r[base + i + 16], cs = cos32[s * 16 + i], sn = sin32[s * 16 + i];
        val = odd ? (x2 * cs + x1 * sn) : (x1 * cs - x2 * sn);
        if (pn == 0) val *= 0.17677669529663687f * LOG2E;
        tens = pn;
    } else if (pn == 8 || pn == 9) {
        const int i = e >> 1, odd = e & 1, base = 2048 + (pn - 8) * 256 + h * 64;
        const float x1 = r[base + i], x2 = r[base + i + 32], cs = cos64[s * 32 + i], sn = sin64[s * 32 + i];
        val = odd ? (x2 * cs + x1 * sn) : (x1 * cs - x2 * sn);
        if (pn == 8) val *= 0.125f * LOG2E;
        tens = pn - 2;
    } else if (pn == 6 || pn == 7) {
        if (pn == 7) return;
        const float a = r[1536 + pc], g = r[1792 + pc];
        P[9 * TENS + (size_t)t * 256 + pc] = (bf16_t)f2bf(a / (1.f + __expf(-g)));
        return;
    } else {
        const int src = (pn <= 5) ? pn * 256 + pc : 2048 + 512 + pc;
        val = r[src];
        if (pn == 3) val *= 0.125f * LOG2E;
        tens = (pn <= 5) ? pn : 8;
    }
    P[(size_t)tens * TENS + (((size_t)b * 4 + h) * SEQ + s) * 64 + e] = (bf16_t)f2bf(val);
}

__device__ __forceinline__ void load64(const bf16_t* p, float (&q)[64]) {
#pragma unroll
    for (int i = 0; i < 8; ++i) { const u32x4 w = *(const u32x4*)(p + 8 * i);
        q[8 * i + 0] = bflo(w.x); q[8 * i + 1] = bfhi(w.x); q[8 * i + 2] = bflo(w.y); q[8 * i + 3] = bfhi(w.y);
        q[8 * i + 4] = bflo(w.z); q[8 * i + 5] = bfhi(w.z); q[8 * i + 6] = bflo(w.w); q[8 * i + 7] = bfhi(w.w); }
}
template <int OFF, int N8> __device__ __forceinline__ float dot_row(const bf16_t* kp, const float (&q)[64]) {
    float s = 0.f;
#pragma unroll
    for (int i = 0; i < N8; ++i) { const u32x4 w = *(const u32x4*)(kp + 8 * i);
        s += q[OFF + 8 * i + 0] * bflo(w.x) + q[OFF + 8 * i + 1] * bfhi(w.x) + q[OFF + 8 * i + 2] * bflo(w.y) + q[OFF + 8 * i + 3] * bfhi(w.y)
           + q[OFF + 8 * i + 4] * bflo(w.z) + q[OFF + 8 * i + 5] * bfhi(w.z) + q[OFF + 8 * i + 6] * bflo(w.w) + q[OFF + 8 * i + 7] * bfhi(w.w); }
    return s;
}
__device__ __forceinline__ void axpy_row(const bf16_t* vp, float a, float (&o)[64]) {
#pragma unroll
    for (int i = 0; i < 8; ++i) { const u32x4 w = *(const u32x4*)(vp + 8 * i);
        o[8 * i + 0] += a * bflo(w.x); o[8 * i + 1] += a * bfhi(w.x); o[8 * i + 2] += a * bflo(w.y); o[8 * i + 3] += a * bfhi(w.y);
        o[8 * i + 4] += a * bflo(w.z); o[8 * i + 5] += a * bfhi(w.z); o[8 * i + 6] += a * bflo(w.w); o[8 * i + 7] += a * bfhi(w.w); }
}
__device__ __forceinline__ void store64_bf16(bf16_t* p, const float (&o)[64]) {
#pragma unroll
    for (int i = 0; i < 8; ++i) { u32x4 w; w.x = pk2(o[8 * i], o[8 * i + 1]); w.y = pk2(o[8 * i + 2], o[8 * i + 3]); w.z = pk2(o[8 * i + 4], o[8 * i + 5]); w.w = pk2(o[8 * i + 6], o[8 * i + 7]); *(u32x4*)(p + 8 * i) = w; }
}
__global__ __launch_bounds__(64) void k_attnA_naive(const bf16_t* P, const float* lamv, const float* subln, bf16_t* concat) {
    const int gq = blockIdx.x * 64 + threadIdx.x, bh = gq >> 11, q = gq & 2047, b = bh >> 2, h = bh & 3;
    const bf16_t* Kb = P + 1 * TENS + (size_t)bh * SEQ * 64; const bf16_t* Vb = P + 2 * TENS + (size_t)bh * SEQ * 64;
    float qv[64]; load64(P + (size_t)gq * 64, qv);
    float m0 = -1e30f, l0 = 0.f, m1 = -1e30f, l1 = 0.f;
    for (int k = 0; k < SEQ; ++k) {
        const float s0 = dot_row<0, 4>(Kb + (size_t)k * 64, qv), s1 = dot_row<32, 4>(Kb + (size_t)k * 64 + 32, qv);
        if (s0 > m0) { l0 *= exp2f(m0 - s0); m0 = s0; } l0 += exp2f(s0 - m0);
        if (s1 > m1) { l1 *= exp2f(m1 - s1); m1 = s1; } l1 += exp2f(s1 - m1);
    }
    const float lam = lamv[0], r0 = 1.f / l0, r1 = lam / l1;
    float o[64];
#pragma unroll
    for (int e = 0; e < 64; ++e) o[e] = 0.f;
    for (int k = 0; k < SEQ; ++k) {
        const float s0 = dot_row<0, 4>(Kb + (size_t)k * 64, qv), s1 = dot_row<32, 4>(Kb + (size_t)k * 64 + 32, qv);
        const float a = exp2f(s0 - m0) * r0 - exp2f(s1 - m1) * r1;
        axpy_row(Vb + (size_t)k * 64, a, o);
    }
    float ss = 0.f;
#pragma unroll
    for (int e = 0; e < 64; ++e) ss += o[e] * o[e];
    const float rs = 1.0f / sqrtf(ss * (1.f / 64.f) + EPS) * lamv[1];
#pragma unroll
    for (int e = 0; e < 64; ++e) o[e] = o[e] * rs * subln[e];
    store64_bf16(concat + ((size_t)b * SEQ + q) * DM + h * 64, o);
}
__global__ __launch_bounds__(64) void k_attnB_naive(const bf16_t* P, const float* rpb, bf16_t* concat) {
    const int gq = blockIdx.x * 64 + threadIdx.x, bh = gq >> 11, s = gq & 2047, b = bh >> 2, h = bh & 3;
    const bf16_t* Kb = P + 4 * TENS + (size_t)bh * SEQ * 64; const bf16_t* Vb = P + 5 * TENS + (size_t)bh * SEQ * 64;
    float qv[64]; load64(P + 3 * TENS + (size_t)gq * 64, qv);
    const int i = s >> 6, j = s & 63, rs = min(max(i - 4, 0), 24), cs = min(max(j - 8, 0), 48);
    float m = -1e30f, l = 0.f, o[64];
#pragma unroll
    for (int e = 0; e < 64; ++e) o[e] = 0.f;
    for (int a = 0; a < 8; ++a) {
        const int row = rs + a, dr = row - i + 7;
        for (int cc = 0; cc < 16; ++cc) {
            const int c = cs + cc, key = row * 64 + c;
            const float sc = dot_row<0, 8>(Kb + (size_t)key * 64, qv) + rpb[(h * 15 + dr) * 31 + (c - j + 15)] * LOG2E;
            if (sc > m) { const float al = exp2f(m - sc); l *= al;
#pragma unroll
                for (int e = 0; e < 64; ++e) o[e] *= al;
                m = sc; }
            const float p = exp2f(sc - m); l += p; axpy_row(Vb + (size_t)key * 64, p, o);
        }
    }
    const float r = 1.f / l;
#pragma unroll
    for (int e = 0; e < 64; ++e) o[e] *= r;
    store64_bf16(concat + ((size_t)b * SEQ + s) * DM + 256 + h * 64, o);
}
__global__ __launch_bounds__(64) void k_attnD_naive(const bf16_t* P, bf16_t* concat) {
    const int gq = blockIdx.x * 64 + threadIdx.x, bh = gq >> 11, t = gq & 2047, b = bh >> 2, h = bh & 3;
    const bf16_t* Kb = P + 7 * TENS + (size_t)bh * SEQ * 64; const bf16_t* Vb = P + 8 * TENS + (size_t)bh * SEQ * 64;
    float qv[64]; load64(P + 6 * TENS + (size_t)gq * 64, qv);
    float m = -1e30f, l = 0.f, o[64];
#pragma unroll
    for (int e = 0; e < 64; ++e) o[e] = 0.f;
    for (int br = 0; br < 3; ++br) {
        const int dil = br == 0 ? 1 : (br == 1 ? 4 : 16);
        for (int mm = -64; mm <= 64; ++mm) {
            const int key = t + mm * dil;
            if (key < 0 || key >= SEQ) continue;
            const float sc = dot_row<0, 8>(Kb + (size_t)key * 64, qv);
            if (sc > m) { const float al = exp2f(m - sc); l *= al;
#pragma unroll
                for (int e = 0; e < 64; ++e) o[e] *= al;
                m = sc; }
            const float p = exp2f(sc - m); l += p; axpy_row(Vb + (size_t)key * 64, p, o);
        }
    }
    const float r = 1.f / l;
#pragma unroll
    for (int e = 0; e < 64; ++e) o[e] *= r;
    store64_bf16(concat + ((size_t)b * SEQ + t) * DM + 768 + h * 64, o);
}
__global__ __launch_bounds__(64) void k_conv_naive(const bf16_t* Z, const float* w_dw, const float* b_dw, const float* g_n, const float* b_n, bf16_t* concat) {
    const int id = blockIdx.x * 64 + threadIdx.x, t = id >> 2, g = id & 3, b = t / SEQ, s = t % SEQ;
    float v[64];
#pragma unroll
    for (int e = 0; e < 64; ++e) v[e] = b_dw[g * 64 + e];
    for (int k = 0; k < 31; ++k) {
        const int sp = s + k - 15; if (sp < 0 || sp >= SEQ) continue;
        const bf16_t* zr = Z + ((size_t)b * SEQ + sp) * 256 + g * 64; const float* wr = w_dw + k * 256 + g * 64;
#pragma unroll
        for (int e = 0; e < 64; ++e) v[e] += bf2f(zr[e]) * wr[e];
    }
    float mu = 0.f;
#pragma unroll
    for (int e = 0; e < 64; ++e) mu += v[e];
    mu *= (1.f / 64.f);
    float var = 0.f;
#pragma unroll
    for (int e = 0; e < 64; ++e) { const float d = v[e] - mu; var += d * d; }
    const float rstd = 1.0f / sqrtf(var * (1.f / 64.f) + EPS);
#pragma unroll
    for (int e = 0; e < 64; ++e) { const float zn = (v[e] - mu) * rstd * g_n[g * 64 + e] + b_n[g * 64 + e]; v[e] = silu_f(zn); }
    store64_bf16(concat + (size_t)t * DM + 512 + g * 64, v);
}

__global__ __launch_bounds__(512) void k_router(const float* x1, const float* g2, const float* modl, const float* w_rg, const float* w_re,
                                                bf16_t* h2, int* eid, float* gate, int* rank, unsigned* gcnt) {
    __shared__ int hist[NE]; __shared__ int basee[NE]; __shared__ int a_e[128]; __shared__ int a_lr[128];
    const int tid = threadIdx.x, lane = tid & 63, wid = tid >> 6;
    if (tid < NE) hist[tid] = 0;
    __syncthreads();
    for (int it = 0; it < 8; ++it) {
        const int lr = wid * 8 + it, row = blockIdx.x * 64 + lr, b = row / SEQ;
        f32x4 v[4]; load_row(x1 + (size_t)row * DM, lane, v);
        const float* m = modl + (size_t)b * 6144;
        norm_mod_row(v, g2, m + 4 * 1024, m + 3 * 1024, lane);
        store_row_bf16(h2 + (size_t)row * DM, lane, v);
        float lg[4] = {0.f, 0.f, 0.f, 0.f};
#pragma unroll
        for (int j = 0; j < 4; ++j)
#pragma unroll
            for (int k = 0; k < 4; ++k) { const f32x4 w = *(const f32x4*)(w_rg + (size_t)(256 * j + 4 * lane + k) * 4); const float xv = v[j][k];
                lg[0] += xv * w.x; lg[1] += xv * w.y; lg[2] += xv * w.z; lg[3] += xv * w.w; }
#pragma unroll
        for (int g = 0; g < 4; ++g) lg[g] = wave_sum(lg[g]);
        int grp = 0; float best = lg[0];
#pragma unroll
        for (int g = 1; g < 4; ++g) if (lg[g] > best) { best = lg[g]; grp = g; }
        float den = 0.f;
#pragma unroll
        for (int g = 0; g < 4; ++g) den += expf(lg[g] - best);
        const float p_grp = 1.f / den;
        float le[8];
#pragma unroll
        for (int e = 0; e < 8; ++e) le[e] = 0.f;
        const float* wre = w_re + (size_t)grp * DM * 8;
#pragma unroll
        for (int j = 0; j < 4; ++j)
#pragma unroll
            for (int k = 0; k < 4; ++k) { const float* wp = wre + (size_t)(256 * j + 4 * lane + k) * 8; const f32x4 w0 = *(const f32x4*)wp, w1 = *(const f32x4*)(wp + 4); const float xv = v[j][k];
                le[0] += xv * w0.x; le[1] += xv * w0.y; le[2] += xv * w0.z; le[3] += xv * w0.w; le[4] += xv * w1.x; le[5] += xv * w1.y; le[6] += xv * w1.z; le[7] += xv * w1.w; }
#pragma unroll
        for (int e = 0; e < 8; ++e) le[e] = wave_sum(le[e]);
        int i0 = 0; float v0 = le[0];
#pragma unroll
        for (int e = 1; e < 8; ++e) if (le[e] > v0) { v0 = le[e]; i0 = e; }
        int i1 = -1; float v1 = -3.0e38f;
#pragma unroll
        for (int e = 0; e < 8; ++e) if (e != i0 && le[e] > v1) { v1 = le[e]; i1 = e; }
        const float e1 = expf(v1 - v0), gt0 = p_grp / (1.f + e1), gt1 = p_grp * e1 / (1.f + e1);
        if (lane == 0) {
            const int ea = grp * 8 + i0, eb = grp * 8 + i1;
            eid[row * 2] = ea; eid[row * 2 + 1] = eb; gate[row * 2] = gt0; gate[row * 2 + 1] = gt1;
            a_e[lr * 2] = ea; a_e[lr * 2 + 1] = eb;
            a_lr[lr * 2] = atomicAdd(&hist[ea], 1); a_lr[lr * 2 + 1] = atomicAdd(&hist[eb], 1);
        }
    }
    __syncthreads();
    if (tid < NE) basee[tid] = (int)atomicAdd(&gcnt[tid], (unsigned)hist[tid]);
    __syncthreads();
    if (tid < 128) rank[blockIdx.x * 128 + tid] = basee[a_e[tid]] + a_lr[tid];
}
__global__ __launch_bounds__(256) void k_scatter(const bf16_t* h2, const int* eid, const int* rank, const unsigned* gcnt, bf16_t* xb, int* tokslot) {
    __shared__ int pstart[NE];
    if (threadIdx.x == 0) { int s = 0; for (int e = 0; e < NE; ++e) { pstart[e] = s; s += ((int)gcnt[e] + 255) / 256 * 256; } }
    __syncthreads();
    const int lane = threadIdx.x & 63, row = blockIdx.x * 4 + (threadIdx.x >> 6);
    const u32x4* src = (const u32x4*)(h2 + (size_t)row * DM);
    const u32x4 a = src[lane], b = src[64 + lane];
#pragma unroll
    for (int k = 0; k < 2; ++k) {
        const int slot = pstart[eid[row * 2 + k]] + rank[row * 2 + k];
        u32x4* dst = (u32x4*)(xb + (size_t)slot * DM); dst[lane] = a; dst[64 + lane] = b;
        if (lane == 0) tokslot[row * 2 + k] = slot;
    }
}
__device__ __forceinline__ void load_row_bf16(const bf16_t* p, int lane, f32x4 (&v)[4]) {
#pragma unroll
    for (int j = 0; j < 4; ++j) { const u32x2 w = *(const u32x2*)(p + 256 * j + 4 * lane); v[j] = (f32x4){bflo(w.x), bfhi(w.x), bflo(w.y), bfhi(w.y)}; }
}
__global__ __launch_bounds__(256) void k_combine(const float* x1, const bf16_t* y, const int* tokslot, const float* gate, const float* modl,
                                                 float* x2, const float* g_next, const float* mod_next, bf16_t* h_next, const float* g_final, float* out) {
    const int lane = threadIdx.x & 63, row = blockIdx.x * 4 + (threadIdx.x >> 6), b = row / SEQ;
    f32x4 v[4], y0[4], y1[4]; load_row(x1 + (size_t)row * DM, lane, v);
    load_row_bf16(y + (size_t)tokslot[row * 2] * DM, lane, y0); load_row_bf16(y + (size_t)tokslot[row * 2 + 1] * DM, lane, y1);
    const float g0 = gate[row * 2], g1 = gate[row * 2 + 1];
    const float* gt2 = modl + (size_t)b * 6144 + 5 * 1024;
#pragma unroll
    for (int j = 0; j < 4; ++j) { const f32x4 gg = *(const f32x4*)(gt2 + 256 * j + 4 * lane); v[j] = v[j] + gg * (y0[j] * g0 + y1[j] * g1); }
    if (out) { norm_mod_row(v, g_final, nullptr, nullptr, lane); store_row_f32(out + (size_t)row * DM, lane, v); }
    else { store_row_f32(x2 + (size_t)row * DM, lane, v);
        const float* m = mod_next + (size_t)b * 6144; norm_mod_row(v, g_next, m + 1024, m, lane); store_row_bf16(h_next + (size_t)row * DM, lane, v); }
}

extern "C" void kernel_launch(void* const* d_in, const int* in_sizes, int n_in, void* d_out, int out_size, void* d_ws, size_t ws_size, hipStream_t stream) {
    if (n_in != 21 || ws_size < WS_END || out_size != T * DM) { fprintf(stderr, "kernel_launch: unexpected shapes (n_in %d, ws %zu, out %d)\n", n_in, ws_size, out_size); return; }
    const float* x = (const float*)d_in[0]; const float* c = (const float*)d_in[1]; const float* w_ada = (const float*)d_in[2]; const float* b_ada = (const float*)d_in[3];
    const float* g_norm1 = (const float*)d_in[4]; const float* g_norm2 = (const float*)d_in[5]; const float* w_in = (const float*)d_in[6];
    const float* diff_lambda = (const float*)d_in[7]; const float* diff_subln = (const float*)d_in[8]; const float* na_rpb = (const float*)d_in[9];
    const float* conv_dw = (const float*)d_in[10]; const float* conv_b = (const float*)d_in[11]; const float* conv_g = (const float*)d_in[12]; const float* conv_bn = (const float*)d_in[13];
    const float* w_out = (const float*)d_in[14]; const float* w_rg = (const float*)d_in[15]; const float* w_re = (const float*)d_in[16];
    const float* w_eg = (const float*)d_in[17]; const float* w_eu = (const float*)d_in[18]; const float* w_ed = (const float*)d_in[19]; const float* g_final = (const float*)d_in[20];
    unsigned char* ws = (unsigned char*)d_ws;
    unsigned* ctl = (unsigned*)(ws + OFF_CTL); float* mod = (float*)(ws + OFF_MOD); float* rot = (float*)(ws + OFF_ROT); float* lamv = (float*)(ws + OFF_LAM);
    int* eid = (int*)(ws + OFF_ROUTE); float* gate = (float*)(ws + OFF_ROUTE + 128 * 1024); int* rank = (int*)(ws + OFF_ROUTE + 256 * 1024); int* tokslot = (int*)(ws + OFF_ROUTE + 384 * 1024);
    float* praw = (float*)(ws + OFF_PRAW); float* X1 = (float*)(ws + OFF_X1); float* X2 = (float*)(ws + OFF_X2); bf16_t* H = (bf16_t*)(ws + OFF_H);
    bf16_t* P = (bf16_t*)(ws + OFF_P); bf16_t* XB = P; bf16_t* Y = P; bf16_t* CC = (bf16_t*)(ws + OFF_C); bf16_t* HDN = CC;
    (void)hipMemsetAsync(ws + OFF_CTL, 0, CTL_BYTES, stream);
    k_tables<<<2048, 64, 0, stream>>>(rot, lamv, diff_lambda);
    k_adaln<<<dim3(24, BATCH, DEPTH), 256, 0, stream>>>(c, w_ada, b_ada, mod);
    k_norm<<<T / 4, 256, 0, stream>>>(x, g_norm1, mod, H);
    for (int l = 0; l < DEPTH; ++l) {
        const float* modl = mod + (size_t)l * BATCH * 6144; const float* xin = l == 0 ? x : X2; unsigned* gcnt = ctl + CW_CNT + l * 64;
        k_gemm_naive<1><<<dim3(P_IN / 64, T / 64), 256, 0, stream>>>(H, DM, BSelPlain{w_in + (size_t)l * DM * P_IN, P_IN, 0}, EpiRaw{praw, P_IN, 0});
        k_postproj<<<dim3(T, 11), 256, 0, stream>>>(praw, rot, P);
        k_attnA_naive<<<BATCH * 4 * SEQ / 64, 64, 0, stream>>>(P, lamv + 2 * l, diff_subln + l * 64, CC);
        k_attnB_naive<<<BATCH * 4 * SEQ / 64, 64, 0, stream>>>(P, na_rpb + (size_t)l * 4 * 15 * 31, CC);
        k_attnD_naive<<<BATCH * 4 * SEQ / 64, 64, 0, stream>>>(P, CC);
        k_conv_naive<<<T * 4 / 64, 64, 0, stream>>>(P + 9 * TENS, conv_dw + l * 31 * 256, conv_b + l * 256, conv_g + l * 256, conv_bn + l * 256, CC);
        k_gemm_naive<1><<<dim3(DM / 64, T / 64), 256, 0, stream>>>(CC, DM, BSelPlain{w_out + (size_t)l * DM * DM, DM, 0}, EpiResid{xin, modl, X1});
        k_router<<<T / 64, 512, 0, stream>>>(X1, g_norm2 + l * DM, modl, w_rg + (size_t)l * DM * 4, w_re + (size_t)l * 4 * DM * 8, H, eid, gate, rank, gcnt);
        k_scatter<<<T / 4, 256, 0, stream>>>(H, eid, rank, gcnt, XB, tokslot);
        k_gemm_naive<2><<<dim3(DE / 64, NSLOT / 64), 256, 0, stream>>>(XB, DM, BSelGU{gcnt, w_eg + (size_t)l * NE * DM * DE, w_eu + (size_t)l * NE * DM * DE}, EpiGU{HDN});
        k_gemm_naive<1><<<dim3(DM / 64, NSLOT / 64), 256, 0, stream>>>(HDN, DE, BSelDN{gcnt, w_ed + (size_t)l * NE * DE * DM}, EpiY{Y});
        if (l + 1 < DEPTH) k_combine<<<T / 4, 256, 0, stream>>>(X1, Y, tokslot, gate, modl, X2, g_norm1 + (l + 1) * DM, mod + (size_t)(l + 1) * BATCH * 6144, H, nullptr, nullptr);
        else k_combine<<<T / 4, 256, 0, stream>>>(X1, Y, tokslot, gate, modl, nullptr, nullptr, nullptr, nullptr, g_final, (float*)d_out);
    }
}
```

```cpp
#include <hip/hip_runtime.h>
#include <cstdio>
#include <cstdint>

constexpr int BATCH = 8, SEQ = 2048, DM = 1024, T = BATCH * SEQ, DEPTH = 2;
constexpr int P_IN = 2816, NE = 32, DE = 512, NSLOT = (T * 2 / 256 + NE) * 256;
constexpr float EPS = 1e-6f, LOG2E = 1.4426950408889634f;
constexpr size_t TENS = (size_t)BATCH * 4 * SEQ * 64;

constexpr size_t MiB = 1u << 20;
constexpr size_t OFF_CTL = 0, CTL_BYTES = 64 * 1024;
constexpr size_t OFF_MOD = 64 * 1024;
constexpr size_t OFF_ROT = 512 * 1024;
constexpr size_t OFF_LAM = 1280 * 1024;
constexpr size_t OFF_ROUTE = 1536 * 1024;
constexpr size_t OFF_W = 2 * MiB;
constexpr size_t OFF_PRAW = 18 * MiB;
constexpr size_t OFF_X1 = 210 * MiB, OFF_X2 = 274 * MiB, OFF_H = 338 * MiB, OFF_P = 370 * MiB, OFF_C = 450 * MiB, WS_END = 490 * MiB;
constexpr int CW_CNT = 4096;

typedef unsigned short bf16_t;
typedef float f32x4 __attribute__((ext_vector_type(4)));
typedef unsigned u32x4 __attribute__((ext_vector_type(4)));
typedef unsigned u32x2 __attribute__((ext_vector_type(2)));

__device__ __forceinline__ unsigned f2bf(float f) { unsigned u = __builtin_bit_cast(unsigned, f); return (u + 0x7fffu + ((u >> 16) & 1u)) >> 16; }
__device__ __forceinline__ unsigned pk2(float lo, float hi) { return f2bf(lo) | (f2bf(hi) << 16); }
__device__ __forceinline__ float bf2f(unsigned short h) { return __builtin_bit_cast(float, (unsigned)h << 16); }
__device__ __forceinline__ float bflo(unsigned w) { return __builtin_bit_cast(float, w << 16); }
__device__ __forceinline__ float bfhi(unsigned w) { return __builtin_bit_cast(float, w & 0xffff0000u); }
__device__ __forceinline__ float wave_sum(float v) {
#pragma unroll
    for (int o = 1; o < 64; o <<= 1) v += __shfl_xor(v, o);
    return v;
}
__device__ __forceinline__ float silu_f(float v) { return v / (1.f + __expf(-v)); }

__global__ void k_tables(float* rot, float* lamv, const float* diff_lambda) {
    const int pos = blockIdx.x, i = threadIdx.x;
    float* cos64 = rot; float* sin64 = rot + 2048 * 32; float* cos32 = rot + 2 * 2048 * 32; float* sin32 = cos32 + 2048 * 16;
    if (i < 32) { const double inv = pow(10000.0, -(double)i / 32.0), a = (double)pos * inv; cos64[pos * 32 + i] = (float)cos(a); sin64[pos * 32 + i] = (float)sin(a); }
    if (i < 16) { const double inv = pow(10000.0, -(double)i / 16.0), a = (double)pos * inv; cos32[pos * 16 + i] = (float)cos(a); sin32[pos * 16 + i] = (float)sin(a); }
    if (pos == 0 && i < DEPTH) {
        const float* lp = diff_lambda + i * 4 * 32; float s01 = 0.f, s23 = 0.f;
        for (int e = 0; e < 32; ++e) { s01 += lp[e] * lp[32 + e]; s23 += lp[64 + e] * lp[96 + e]; }
        const float lam_init = 0.8f - 0.6f * expf(-0.3f * (float)i);
        lamv[2 * i] = expf(s01) - expf(s23) + lam_init; lamv[2 * i + 1] = 1.f - lam_init;
    }
}
__global__ void k_adaln(const float* c, const float* w_ada, const float* b_ada, float* mod) {
    const int n = blockIdx.x * 256 + threadIdx.x, b = blockIdx.y, l = blockIdx.z;
    const float* w = w_ada + (size_t)l * DM * 6144 + n; const float* cb = c + b * DM;
    float acc = b_ada[l * 6144 + n];
    for (int d = 0; d < DM; ++d) acc += silu_f(cb[d]) * w[(size_t)d * 6144];
    mod[((size_t)l * BATCH + b) * 6144 + n] = acc;
}
__device__ __forceinline__ void load_row(const float* xr, int lane, f32x4 (&v)[4]) {
#pragma unroll
    for (int j = 0; j < 4; ++j) v[j] = *(const f32x4*)(xr + 256 * j + 4 * lane);
}
__device__ __forceinline__ void norm_mod_row(f32x4 (&v)[4], const float* g, const float* sc, const float* sh, int lane) {
    float s = 0.f;
#pragma unroll
    for (int j = 0; j < 4; ++j) s += (v[j].x * v[j].x + v[j].y * v[j].y) + (v[j].z * v[j].z + v[j].w * v[j].w);
    const float rstd = 1.0f / sqrtf(wave_sum(s) * (1.f / DM) + EPS);
#pragma unroll
    for (int j = 0; j < 4; ++j) {
        const f32x4 gg = *(const f32x4*)(g + 256 * j + 4 * lane);
        f32x4 y = v[j] * rstd * gg;
        if (sc) { const f32x4 a = *(const f32x4*)(sc + 256 * j + 4 * lane), b = *(const f32x4*)(sh + 256 * j + 4 * lane); y = y * (1.f + a) + b; }
        v[j] = y;
    }
}
__device__ __forceinline__ void store_row_bf16(bf16_t* o, int lane, const f32x4 (&v)[4]) {
#pragma unroll
    for (int j = 0; j < 4; ++j) { u32x2 w; w.x = pk2(v[j].x, v[j].y); w.y = pk2(v[j].z, v[j].w); *(u32x2*)(o + 256 * j + 4 * lane) = w; }
}
__device__ __forceinline__ void store_row_f32(float* o, int lane, const f32x4 (&v)[4]) {
#pragma unroll
    for (int j = 0; j < 4; ++j) *(f32x4*)(o + 256 * j + 4 * lane) = v[j];
}
__global__ __launch_bounds__(256) void k_norm(const float* x, const float* g, const float* modl, bf16_t* h) {
    const int lane = threadIdx.x & 63, row = blockIdx.x * 4 + (threadIdx.x >> 6), b = row / SEQ;
    f32x4 v[4]; load_row(x + (size_t)row * DM, lane, v);
    const float* m = modl + (size_t)b * 6144;
    norm_mod_row(v, g, m + 1024, m, lane);
    store_row_bf16(h + (size_t)row * DM, lane, v);
}

template <int NB, class BSel, class Epi>
__global__ __launch_bounds__(256) void k_gemm_naive(const bf16_t* A, long long K_, BSel bsel, Epi epi) {
    const int K = (int)K_;
    __shared__ float As[16][68];
    __shared__ float Bs[NB][16][64];
    const int tid = threadIdx.x, tx = tid & 15, ty = tid >> 4, rt = blockIdx.y, ct = blockIdx.x;
    const float* Bp[NB]; int ldb;
    if (!bsel(rt, Bp, ldb)) return;
    float acc[NB][4][4];
#pragma unroll
    for (int q = 0; q < NB; ++q)
#pragma unroll
        for (int i = 0; i < 4; ++i)
#pragma unroll
            for (int j = 0; j < 4; ++j) acc[q][i][j] = 0.f;
    const int ar = tid >> 2, ak = (tid & 3) * 4, bk = tid >> 4, bn = (tid & 15) * 4;
    for (int k0 = 0; k0 < K; k0 += 16) {
        const u32x2 aw = *(const u32x2*)(A + (size_t)(rt * 64 + ar) * K + k0 + ak);
        As[ak + 0][ar] = bflo(aw.x); As[ak + 1][ar] = bfhi(aw.x); As[ak + 2][ar] = bflo(aw.y); As[ak + 3][ar] = bfhi(aw.y);
#pragma unroll
        for (int q = 0; q < NB; ++q) *(f32x4*)&Bs[q][bk][bn] = *(const f32x4*)(Bp[q] + (size_t)(k0 + bk) * ldb + ct * 64 + bn);
        __syncthreads();
#pragma unroll
        for (int k = 0; k < 16; ++k) {
            const f32x4 a = *(const f32x4*)&As[k][ty * 4];
#pragma unroll
            for (int q = 0; q < NB; ++q) { const f32x4 b = *(const f32x4*)&Bs[q][k][tx * 4];
#pragma unroll
                for (int i = 0; i < 4; ++i)
#pragma unroll
                    for (int j = 0; j < 4; ++j) acc[q][i][j] += a[i] * b[j]; }
        }
        __syncthreads();
    }
#pragma unroll
    for (int i = 0; i < 4; ++i)
#pragma unroll
        for (int j = 0; j < 4; ++j) { float v[NB];
#pragma unroll
            for (int q = 0; q < NB; ++q) v[q] = acc[q][i][j];
            epi(rt * 64 + ty * 4 + i, ct * 64 + tx * 4 + j, v); }
}
struct BSelPlain { const float* B; int ldb; int pad; __device__ bool operator()(int, const float* (&Bp)[1], int& l) const { Bp[0] = B; l = ldb; return true; } };
struct EpiRaw { float* C; int ldc; int pad; __device__ void operator()(int r, int c, const float (&v)[1]) const { C[(size_t)r * ldc + c] = v[0]; } };
struct EpiResid { const float* xin; const float* modl; float* out; __device__ void operator()(int r, int c, const float (&v)[1]) const {
    const int b = r / SEQ; out[(size_t)r * DM + c] = xin[(size_t)r * DM + c] + modl[(size_t)b * 6144 + 2048 + c] * v[0]; } };
__device__ __forceinline__ int expert_of_row(const unsigned* cnt, int row, int& total) {
    int start = 0, e_found = -1;
    for (int e = 0; e < NE; ++e) { const int pad = ((int)cnt[e] + 255) / 256 * 256; if (row >= start && row < start + pad) e_found = e; start += pad; }
    total = start; return e_found;
}
struct BSelGU { const unsigned* cnt; const float* wg; const float* wu; __device__ bool operator()(int rt, const float* (&Bp)[2], int& l) const {
    int total; const int e = expert_of_row(cnt, rt * 64, total); if (e < 0) return false;
    Bp[0] = wg + (size_t)e * DM * DE; Bp[1] = wu + (size_t)e * DM * DE; l = DE; return true; } };
struct EpiGU { bf16_t* hdn; __device__ void operator()(int r, int c, const float (&v)[2]) const { hdn[(size_t)r * DE + c] = (bf16_t)f2bf(silu_f(v[0]) * v[1]); } };
struct BSelDN { const unsigned* cnt; const float* wd; __device__ bool operator()(int rt, const float* (&Bp)[1], int& l) const {
    int total; const int e = expert_of_row(cnt, rt * 64, total); if (e < 0) return false;
    Bp[0] = wd + (size_t)e * DE * DM; l = DM; return true; } };
struct EpiY { bf16_t* y; __device__ void operator()(int r, int c, const float (&v)[1]) const { y[(size_t)r * DM + c] = (bf16_t)f2bf(v[0]); } };

__global__ __launch_bounds__(256) void k_postproj(const float* raw, const float* rot, bf16_t* P) {
    const int t = blockIdx.x, pn = blockIdx.y, pc = threadIdx.x, b = t / SEQ, s = t % SEQ;
    const float* r = raw + (size_t)t * P_IN;
    const float* cos64 = rot; const float* sin64 = rot + 2048 * 32; const float* cos32 = rot + 2 * 2048 * 32; const float* sin32 = cos32 + 2048 * 16;
    const int h = pc >> 6, e = pc & 63;
    float val; int tens;
    if (pn == 0 || pn == 1) {
        const int cmap = e >> 5, p = e & 31, i = p >> 1, odd = p & 1, base = pn * 256 + h * 64 + cmap * 32;
        const float x1 = r[base + i], x2 = r[base + i + 16], cs = cos32[s * 16 + i], sn = sin32[s * 16 + i];
        val = odd ? (x2 * cs + x1 * sn) : (x1 * cs - x2 * sn);
        if (pn == 0) val *= 0.17677669529663687f * LOG2E;
        tens = pn;
    } else if (pn == 8 || pn == 9) {
        const int i = e >> 1, odd = e & 1, base = 2048 + (pn - 8) * 256 + h * 64;
        const float x1 = r[base + i], x2 = r[base + i + 32], cs = cos64[s * 32 + i], sn = sin64[s * 32 + i];
        val = odd ? (x2 * cs + x1 * sn) : (x1 * cs - x2 * sn);
        if (pn == 8) val *= 0.125f * LOG2E;
        tens = pn - 2;
    } else if (pn == 6 || pn == 7) {
        if (pn == 7) return;
        const float a = r[1536 + pc], g = r[1792 + pc];
        P[9 * TENS + (size_t)t * 256 + pc] = (bf16_t)f2bf(a / (1.f + __expf(-g)));
        return;
    } else {
        const int src = (pn <= 5) ? pn * 256 + pc : 2048 + 512 + pc;
        val = r[src];
        if (pn == 3) val *= 0.125f * LOG2E;
        tens = (pn <= 5) ? pn : 8;
    }
    P[(size_t)tens * TENS + (((size_t)b * 4 + h) * SEQ + s) * 64 + e] = (bf16_t)f2bf(val);
}

__device__ __forceinline__ void load64(const bf16_t* p, float (&q)[64]) {
#pragma unroll
    for (int i = 0; i < 8; ++i) { const u32x4 w = *(const u32x4*)(p + 8 * i);
        q[8 * i + 0] = bflo(w.x); q[8 * i + 1] = bfhi(w.x); q[8 * i + 2] = bflo(w.y); q[8 * i + 3] = bfhi(w.y);
        q[8 * i + 4] = bflo(w.z); q[8 * i + 5] = bfhi(w.z); q[8 * i + 6] = bflo(w.w); q[8 * i + 7] = bfhi(w.w); }
}
template <int OFF, int N8> __device__ __forceinline__ float dot_row(const bf16_t* kp, const float (&q)[64]) {
    float s = 0.f;
#pragma unroll
    for (int i = 0; i < N8; ++i) { const u32x4 w = *(const u32x4*)(kp + 8 * i);
        s += q[OFF + 8 * i + 0] * bflo(w.x) + q[OFF + 8 * i + 1] * bfhi(w.x) + q[OFF + 8 * i + 2] * bflo(w.y) + q[OFF + 8 * i + 3] * bfhi(w.y)
           + q[OFF + 8 * i + 4] * bflo(w.z) + q[OFF + 8 * i + 5] * bfhi(w.z) + q[OFF + 8 * i + 6] * bflo(w.w) + q[OFF + 8 * i + 7] * bfhi(w.w); }
    return s;
}
__device__ __forceinline__ void axpy_row(const bf16_t* vp, float a, float (&o)[64]) {
#pragma unroll
    for (int i = 0; i < 8; ++i) { const u32x4 w = *(const u32x4*)(vp + 8 * i);
        o[8 * i + 0] += a * bflo(w.x); o[8 * i + 1] += a * bfhi(w.x); o[8 * i + 2] += a * bflo(w.y); o[8 * i + 3] += a * bfhi(w.y);
        o[8 * i + 4] += a * bflo(w.z); o[8 * i + 5] += a * bfhi(w.z); o[8 * i + 6] += a * bflo(w.w); o[8 * i + 7] += a * bfhi(w.w); }
}
__device__ __forceinline__ void store64_bf16(bf16_t* p, const float (&o)[64]) {
#pragma unroll
    for (int i = 0; i < 8; ++i) { u32x4 w; w.x = pk2(o[8 * i], o[8 * i + 1]); w.y = pk2(o[8 * i + 2], o[8 * i + 3]); w.z = pk2(o[8 * i + 4], o[8 * i + 5]); w.w = pk2(o[8 * i + 6], o[8 * i + 7]); *(u32x4*)(p + 8 * i) = w; }
}
__global__ __launch_bounds__(64) void k_attnA_naive(const bf16_t* P, const float* lamv, const float* subln, bf16_t* concat) {
    const int gq = blockIdx.x * 64 + threadIdx.x, bh = gq >> 11, q = gq & 2047, b = bh >> 2, h = bh & 3;
    const bf16_t* Kb = P + 1 * TENS + (size_t)bh * SEQ * 64; const bf16_t* Vb = P + 2 * TENS + (size_t)bh * SEQ * 64;
    float qv[64]; load64(P + (size_t)gq * 64, qv);
    float m0 = -1e30f, l0 = 0.f, m1 = -1e30f, l1 = 0.f;
    for (int k = 0; k < SEQ; ++k) {
        const float s0 = dot_row<0, 4>(Kb + (size_t)k * 64, qv), s1 = dot_row<32, 4>(Kb + (size_t)k * 64 + 32, qv);
        if (s0 > m0) { l0 *= exp2f(m0 - s0); m0 = s0; } l0 += exp2f(s0 - m0);
        if (s1 > m1) { l1 *= exp2f(m1 - s1); m1 = s1; } l1 += exp2f(s1 - m1);
    }
    const float lam = lamv[0], r0 = 1.f / l0, r1 = lam / l1;
    float o[64];
#pragma unroll
    for (int e = 0; e < 64; ++e) o[e] = 0.f;
    for (int k = 0; k < SEQ; ++k) {
        const float s0 = dot_row<0, 4>(Kb + (size_t)k * 64, qv), s1 = dot_row<32, 4>(Kb + (size_t)k * 64 + 32, qv);
        const float a = exp2f(s0 - m0) * r0 - exp2f(s1 - m1) * r1;
        axpy_row(Vb + (size_t)k * 64, a, o);
    }
    float ss = 0.f;
#pragma unroll
    for (int e = 0; e < 64; ++e) ss += o[e] * o[e];
    const float rs = 1.0f / sqrtf(ss * (1.f / 64.f) + EPS) * lamv[1];
#pragma unroll
    for (int e = 0; e < 64; ++e) o[e] = o[e] * rs * subln[e];
    store64_bf16(concat + ((size_t)b * SEQ + q) * DM + h * 64, o);
}
__global__ __launch_bounds__(64) void k_attnB_naive(const bf16_t* P, const float* rpb, bf16_t* concat) {
    const int gq = blockIdx.x * 64 + threadIdx.x, bh = gq >> 11, s = gq & 2047, b = bh >> 2, h = bh & 3;
    const bf16_t* Kb = P + 4 * TENS + (size_t)bh * SEQ * 64; const bf16_t* Vb = P + 5 * TENS + (size_t)bh * SEQ * 64;
    float qv[64]; load64(P + 3 * TENS + (size_t)gq * 64, qv);
    const int i = s >> 6, j = s & 63, rs = min(max(i - 4, 0), 24), cs = min(max(j - 8, 0), 48);
    float m = -1e30f, l = 0.f, o[64];
#pragma unroll
    for (int e = 0; e < 64; ++e) o[e] = 0.f;
    for (int a = 0; a < 8; ++a) {
        const int row = rs + a, dr = row - i + 7;
        for (int cc = 0; cc < 16; ++cc) {
            const int c = cs + cc, key = row * 64 + c;
            const float sc = dot_row<0, 8>(Kb + (size_t)key * 64, qv) + rpb[(h * 15 + dr) * 31 + (c - j + 15)] * LOG2E;
            if (sc > m) { const float al = exp2f(m - sc); l *= al;
#pragma unroll
                for (int e = 0; e < 64; ++e) o[e] *= al;
                m = sc; }
            const float p = exp2f(sc - m); l += p; axpy_row(Vb + (size_t)key * 64, p, o);
        }
    }
    const float r = 1.f / l;
#pragma unroll
    for (int e = 0; e < 64; ++e) o[e] *= r;
    store64_bf16(concat + ((size_t)b * SEQ + s) * DM + 256 + h * 64, o);
}
__global__ __launch_bounds__(64) void k_attnD_naive(const bf16_t* P, bf16_t* concat) {
    const int gq = blockIdx.x * 64 + threadIdx.x, bh = gq >> 11, t = gq & 2047, b = bh >> 2, h = bh & 3;
    const bf16_t* Kb = P + 7 * TENS + (size_t)bh * SEQ * 64; const bf16_t* Vb = P + 8 * TENS + (size_t)bh * SEQ * 64;
    float qv[64]; load64(P + 6 * TENS + (size_t)gq * 64, qv);
    float m = -1e30f, l = 0.f, o[64];
#pragma unroll
    for (int e = 0; e < 64; ++e) o[e] = 0.f;
    for (int br = 0; br < 3; ++br) {
        const int dil = br == 0 ? 1 : (br == 1 ? 4 : 16);
        for (int mm = -64; mm <= 64; ++mm) {
            const int key = t + mm * dil;
            if (key < 0 || key >= SEQ) continue;
            const float sc = dot_row<0, 8>(Kb + (size_t)key * 64, qv);
            if (sc > m) { const float al = exp2f(m - sc); l *= al;
#pragma unroll
                for (int e = 0; e < 64; ++e) o[e] *= al;
                m = sc; }
            const float p = exp2f(sc - m); l += p; axpy_row(Vb + (size_t)key * 64, p, o);
        }
    }
    const float r = 1.f / l;
#pragma unroll
    for (int e = 0; e < 64; ++e) o[e] *= r;
    store64_bf16(concat + ((size_t)b * SEQ + t) * DM + 768 + h * 64, o);
}
__global__ __launch_bounds__(64) void k_conv_naive(const bf16_t* Z, const float* w_dw, const float* b_dw, const float* g_n, const float* b_n, bf16_t* concat) {
    const int id = blockIdx.x * 64 + threadIdx.x, t = id >> 2, g = id & 3, b = t / SEQ, s = t % SEQ;
    float v[64];
#pragma unroll
    for (int e = 0; e < 64; ++e) v[e] = b_dw[g * 64 + e];
    for (int k = 0; k < 31; ++k) {
        const int sp = s + k - 15; if (sp < 0 || sp >= SEQ) continue;
        const bf16_t* zr = Z + ((size_t)b * SEQ + sp) * 256 + g * 64; const float* wr = w_dw + k * 256 + g * 64;
#pragma unroll
        for (int e = 0; e < 64; ++e) v[e] += bf2f(zr[e]) * wr[e];
    }
    float mu = 0.f;
#pragma unroll
    for (int e = 0; e < 64; ++e) mu += v[e];
    mu *= (1.f / 64.f);
    float var = 0.f;
#pragma unroll
    for (int e = 0; e < 64; ++e) { const float d = v[e] - mu; var += d * d; }
    const float rstd = 1.0f / sqrtf(var * (1.f / 64.f) + EPS);
#pragma unroll
    for (int e = 0; e < 64; ++e) { const float zn = (v[e] - mu) * rstd * g_n[g * 64 + e] + b_n[g * 64 + e]; v[e] = silu_f(zn); }
    store64_bf16(concat + (size_t)t * DM + 512 + g * 64, v);
}

__global__ __launch_bounds__(512) void k_router(const float* x1, const float* g2, const float* modl, const float* w_rg, const float* w_re,
                                                bf16_t* h2, int* eid, float* gate, int* rank, unsigned* gcnt) {
    __shared__ int hist[NE]; __shared__ int basee[NE]; __shared__ int a_e[128]; __shared__ int a_lr[128];
    const int tid = threadIdx.x, lane = tid & 63, wid = tid >> 6;
    if (tid < NE) hist[tid] = 0;
    __syncthreads();
    for (int it = 0; it < 8; ++it) {
        const int lr = wid * 8 + it, row = blockIdx.x * 64 + lr, b = row / SEQ;
        f32x4 v[4]; load_row(x1 + (size_t)row * DM, lane, v);
        const float* m = modl + (size_t)b * 6144;
        norm_mod_row(v, g2, m + 4 * 1024, m + 3 * 1024, lane);
        store_row_bf16(h2 + (size_t)row * DM, lane, v);
        float lg[4] = {0.f, 0.f, 0.f, 0.f};
#pragma unroll
        for (int j = 0; j < 4; ++j)
#pragma unroll
            for (int k = 0; k < 4; ++k) { const f32x4 w = *(const f32x4*)(w_rg + (size_t)(256 * j + 4 * lane + k) * 4); const float xv = v[j][k];
                lg[0] += xv * w.x; lg[1] += xv * w.y; lg[2] += xv * w.z; lg[3] += xv * w.w; }
#pragma unroll
        for (int g = 0; g < 4; ++g) lg[g] = wave_sum(lg[g]);
        int grp = 0; float best = lg[0];
#pragma unroll
        for (int g = 1; g < 4; ++g) if (lg[g] > best) { best = lg[g]; grp = g; }
        float den = 0.f;
#pragma unroll
        for (int g = 0; g < 4; ++g) den += expf(lg[g] - best);
        const float p_grp = 1.f / den;
        float le[8];
#pragma unroll
        for (int e = 0; e < 8; ++e) le[e] = 0.f;
        const float* wre = w_re + (size_t)grp * DM * 8;
#pragma unroll
        for (int j = 0; j < 4; ++j)
#pragma unroll
            for (int k = 0; k < 4; ++k) { const float* wp = wre + (size_t)(256 * j + 4 * lane + k) * 8; const f32x4 w0 = *(const f32x4*)wp, w1 = *(const f32x4*)(wp + 4); const float xv = v[j][k];
                le[0] += xv * w0.x; le[1] += xv * w0.y; le[2] += xv * w0.z; le[3] += xv * w0.w; le[4] += xv * w1.x; le[5] += xv * w1.y; le[6] += xv * w1.z; le[7] += xv * w1.w; }
#pragma unroll
        for (int e = 0; e < 8; ++e) le[e] = wave_sum(le[e]);
        int i0 = 0; float v0 = le[0];
#pragma unroll
        for (int e = 1; e < 8; ++e) if (le[e] > v0) { v0 = le[e]; i0 = e; }
        int i1 = -1; float v1 = -3.0e38f;
#pragma unroll
        for (int e = 0; e < 8; ++e) if (e != i0 && le[e] > v1) { v1 = le[e]; i1 = e; }
        const float e1 = expf(v1 - v0), gt0 = p_grp / (1.f + e1), gt1 = p_grp * e1 / (1.f + e1);
        if (lane == 0) {
            const int ea = grp * 8 + i0, eb = grp * 8 + i1;
            eid[row * 2] = ea; eid[row * 2 + 1] = eb; gate[row * 2] = gt0; gate[row * 2 + 1] = gt1;
            a_e[lr * 2] = ea; a_e[lr * 2 + 1] = eb;
            a_lr[lr * 2] = atomicAdd(&hist[ea], 1); a_lr[lr * 2 + 1] = atomicAdd(&hist[eb], 1);
        }
    }
    __syncthreads();
    if (tid < NE) basee[tid] = (int)atomicAdd(&gcnt[tid], (unsigned)hist[tid]);
    __syncthreads();
    if (tid < 128) rank[blockIdx.x * 128 + tid] = basee[a_e[tid]] + a_lr[tid];
}
__global__ __launch_bounds__(256) void k_scatter(const bf16_t* h2, const int* eid, const int* rank, const unsigned* gcnt, bf16_t* xb, int* tokslot) {
    __shared__ int pstart[NE];
    if (threadIdx.x == 0) { int s = 0; for (int e = 0; e < NE; ++e) { pstart[e] = s; s += ((int)gcnt[e] + 255) / 256 * 256; } }
    __syncthreads();
    const int lane = threadIdx.x & 63, row = blockIdx.x * 4 + (threadIdx.x >> 6);
    const u32x4* src = (const u32x4*)(h2 + (size_t)row * DM);
    const u32x4 a = src[lane], b = src[64 + lane];
#pragma unroll
    for (int k = 0; k < 2; ++k) {
        const int slot = pstart[eid[row * 2 + k]] + rank[row * 2 + k];
        u32x4* dst = (u32x4*)(xb + (size_t)slot * DM); dst[lane] = a; dst[64 + lane] = b;
        if (lane == 0) tokslot[row * 2 + k] = slot;
    }
}
__device__ __forceinline__ void load_row_bf16(const bf16_t* p, int lane, f32x4 (&v)[4]) {
#pragma unroll
    for (int j = 0; j < 4; ++j) { const u32x2 w = *(const u32x2*)(p + 256 * j + 4 * lane); v[j] = (f32x4){bflo(w.x), bfhi(w.x), bflo(w.y), bfhi(w.y)}; }
}
__global__ __launch_bounds__(256) void k_combine(const float* x1, const bf16_t* y, const int* tokslot, const float* gate, const float* modl,
                                                 float* x2, const float* g_next, const float* mod_next, bf16_t* h_next, const float* g_final, float* out) {
    const int lane = threadIdx.x & 63, row = blockIdx.x * 4 + (threadIdx.x >> 6), b = row / SEQ;
    f32x4 v[4], y0[4], y1[4]; load_row(x1 + (size_t)row * DM, lane, v);
    load_row_bf16(y + (size_t)tokslot[row * 2] * DM, lane, y0); load_row_bf16(y + (size_t)tokslot[row * 2 + 1] * DM, lane, y1);
    const float g0 = gate[row * 2], g1 = gate[row * 2 + 1];
    const float* gt2 = modl + (size_t)b * 6144 + 5 * 1024;
#pragma unroll
    for (int j = 0; j < 4; ++j) { const f32x4 gg = *(const f32x4*)(gt2 + 256 * j + 4 * lane); v[j] = v[j] + gg * (y0[j] * g0 + y1[j] * g1); }
    if (out) { norm_mod_row(v, g_final, nullptr, nullptr, lane); store_row_f32(out + (size_t)row * DM, lane, v); }
    else { store_row_f32(x2 + (size_t)row * DM, lane, v);
        const float* m = mod_next + (size_t)b * 6144; norm_mod_row(v, g_next, m + 1024, m, lane); store_row_bf16(h_next + (size_t)row * DM, lane, v); }
}

namespace pg8 {
#define PG8_LAS __attribute__((address_space(3)))
typedef unsigned short bf16_t;
typedef short bf16x8 __attribute__((ext_vector_type(8)));
typedef float f32x4 __attribute__((ext_vector_type(4)));
typedef unsigned u32x4 __attribute__((ext_vector_type(4)));
constexpr int BM = 256, BK = 64, HALF = 128, HTB = HALF * BK * 2  , STAGE_BYTES = 8 * HTB, NXCD = 8, WGM = 8;

__host__ __device__ __forceinline__ int lds_byte(int r, int c) { const int st = (r >> 4) * 2 + (c >> 5), rr = r & 15, cc = c & 31, ob = rr * 64 + cc * 2; return st * 1024 + (ob ^ (((ob >> 9) & 1) << 5)); }
__host__ __device__ __forceinline__ void stage_rc(int b, int& R, int& C) { const int st = b / 1024, sb = b % 1024, swz = sb ^ (((sb >> 9) & 1) << 5); R = (st >> 1) * 16 + swz / 64; C = (st & 1) * 32 + (swz % 64) / 2; }
__host__ __device__ __forceinline__ int perm32(int rho) { const int n = rho >> 4, i = rho & 15; return 8 * (i >> 2) + 4 * n + (i & 3); }

struct Unit { int pm, pn; };
struct Gemm { const bf16_t* A; const bf16_t* Bt; int M, N, K; };

struct StaticOrder {
    int nM, nN, nwg, G, c;
    __host__ __device__ void init(int M, int N, int G_, int c_) { nM = M / BM; nN = N / BM; nwg = nM * nN; G = G_; c = c_; }
    __host__ __device__ bool next(int i, Unit& u) const {
        const long L = (long)i * G + c; if (L >= nwg) return false;
        int wgid = (int)L; { const int q = nwg / NXCD, r = nwg % NXCD, xcd = wgid % NXCD, off = wgid / NXCD; wgid = (xcd < r ? xcd * (q + 1) : r * (q + 1) + (xcd - r) * q) + off; }
        const int nig = WGM * nN, gid = wgid / nig, fm = gid * WGM, gsz = (nM - fm) < WGM ? (nM - fm) : WGM;
        u.pm = fm + ((wgid % nig) % gsz); u.pn = (wgid % nig) / gsz; return true;
    }
    __device__ __forceinline__ void a_ready(const Unit&) const {}
    __device__ __forceinline__ void done(const Unit&) const {}
};

__device__ __forceinline__ unsigned cvt_pk_bf16(float lo, float hi) { unsigned r; asm volatile("v_cvt_pk_bf16_f32 %0, %1, %2" : "=v"(r) : "v"(lo), "v"(hi)); return r; }
typedef float f32x2 __attribute__((ext_vector_type(2)));
template <class Epi, class Sched, bool ALIGN_EPI = false, bool SP2 = false>
__device__ __forceinline__ void gemm_phase(PG8_LAS unsigned char* lds, const Gemm g, const Sched& S, const Epi& E) {
    int tid_ = threadIdx.x; asm volatile("" : "+v"(tid_)); const int tid = tid_, wid = __builtin_amdgcn_readfirstlane(tid >> 6), lane = tid & 63, wr = wid >> 2, wc = wid & 3, fr = lane & 15, fq = lane >> 4;
    const int K = g.K, nt = K / BK;
    unsigned voffA[2], voffB[2];
#pragma unroll
    for (int i = 0; i < 2; ++i) { int R, C; stage_rc(tid * 16 + i * 8192, R, C); const int Rb = Epi::PERM ? ((R & ~31) + perm32(R & 31)) : R;
        voffA[i] = (unsigned)(R * K + C) * 2u; voffB[i] = (unsigned)(Rb * K + C) * 2u; }
    const size_t kstep = (size_t)(BK * 2);
    const size_t hstep = (size_t)HALF * K * 2;
    const size_t tstep = 2 * hstep;
    const unsigned ldsw = (unsigned)wid * 1024u;
    const int aoff = lds_byte(wr * 64 + fr, fq * 8), boff = lds_byte(wc * 32 + fr, fq * 8);
#define PG8_SA(b, h) (((b) * 2 + (h)) * HTB)
#define PG8_SB(b, h) ((4 + (b) * 2 + (h)) * HTB)
#define PG8_STAGE(bufoff, gbase, voff) do { _Pragma("unroll") for (int _i = 0; _i < 2; ++_i) \
        __builtin_amdgcn_global_load_lds((const unsigned*)((const char*)(gbase) + (voff)[_i]), (PG8_LAS unsigned*)(lds + (bufoff) + ldsw + _i * 8192), 16, 0, 0); } while (0)
#define PG8_LDA(dst, b, h) do { _Pragma("unroll") for (int m = 0; m < 4; ++m) _Pragma("unroll") for (int k = 0; k < 2; ++k) dst[m][k] = *(const PG8_LAS bf16x8*)(lds + PG8_SA(b, h) + aoff + m * 2048 + k * 1024); } while (0)
#define PG8_LDB(dst, b, h) do { _Pragma("unroll") for (int n = 0; n < 2; ++n) _Pragma("unroll") for (int k = 0; k < 2; ++k) dst[n][k] = *(const PG8_LAS bf16x8*)(lds + PG8_SB(b, h) + boff + n * 2048 + k * 1024); } while (0)
#define PG8_MMA(ai, bj, At, Bt) do { __builtin_amdgcn_s_setprio(1); _Pragma("unroll") for (int m = 0; m < 4; ++m) _Pragma("unroll") for (int n = 0; n < 2; ++n) _Pragma("unroll") for (int k = 0; k < 2; ++k) \
        acc[ai][bj][m][n] = __builtin_amdgcn_mfma_f32_16x16x32_bf16(Bt[n][k], At[m][k], acc[ai][bj][m][n], 0, 0, 0); __builtin_amdgcn_s_setprio(0); } while (0)
#define PG8_WAIT_V(n) asm volatile("s_waitcnt vmcnt(" #n ")" ::: "memory")
#define PG8_WAIT_L(n) asm volatile("s_waitcnt lgkmcnt(" #n ")" ::: "memory")
#define PG8_BAR __builtin_amdgcn_s_barrier()
#define PG8_SCHED __builtin_amdgcn_sched_barrier(0)
    Unit cur, nxt; int ui = 0;
    if (!S.next(0, cur)) return;
    f32x4 acc[2][2][4][2];
#pragma unroll
    for (int a = 0; a < 2; ++a)
#pragma unroll
        for (int b = 0; b < 2; ++b)
#pragma unroll
            for (int m = 0; m < 4; ++m)
#pragma unroll
                for (int n = 0; n < 2; ++n) acc[a][b][m][n] = (f32x4){0.f, 0.f, 0.f, 0.f};
    bf16x8 At[4][2], B0[2][2], B1[2][2];
    const char* cA = (const char*)g.A + (size_t)cur.pm * tstep; const char* cB = (const char*)g.Bt + (size_t)cur.pn * tstep;
    S.a_ready(cur);
    if constexpr (SP2) {
        PG8_STAGE(PG8_SB(0, 0), cB, voffB); PG8_STAGE(PG8_SB(0, 1), cB + hstep, voffB); PG8_STAGE(PG8_SA(0, 0), cA, voffA); PG8_STAGE(PG8_SA(0, 1), cA + hstep, voffA);
        if (wr == 1) PG8_BAR;
        PG8_WAIT_V(2); PG8_BAR;
        PG8_STAGE(PG8_SB(1, 0), cB + kstep, voffB); PG8_STAGE(PG8_SA(1, 0), cA + kstep, voffA); PG8_STAGE(PG8_SB(1, 1), cB + hstep + kstep, voffB);
        PG8_WAIT_V(6); PG8_BAR;
    } else {
        PG8_STAGE(PG8_SB(0, 0), cB, voffB); PG8_STAGE(PG8_SA(0, 0), cA, voffA); PG8_STAGE(PG8_SB(0, 1), cB + hstep, voffB); PG8_STAGE(PG8_SA(0, 1), cA + hstep, voffA);
        if (wr == 1) PG8_BAR;
        PG8_WAIT_V(4); PG8_BAR;
        PG8_STAGE(PG8_SB(1, 0), cB + kstep, voffB); PG8_STAGE(PG8_SA(1, 0), cA + kstep, voffA); PG8_STAGE(PG8_SB(1, 1), cB + hstep + kstep, voffB);
        PG8_WAIT_V(6); PG8_BAR;
    }
    for (;;) {
        const bool has_next = S.next(ui + 1, nxt);
        const char* nA = has_next ? (const char*)g.A + (size_t)nxt.pm * tstep : cA; const char* nB = has_next ? (const char*)g.Bt + (size_t)nxt.pn * tstep : cB;
        for (int t = 0; t < nt; t += 2) {
            const bool last = (t == nt - 2);
            const char* a1 = cA + (size_t)(t + 1) * kstep;
            const char* a2 = last ? nA : cA + (size_t)(t + 2) * kstep; const char* b2 = last ? nB : cB + (size_t)(t + 2) * kstep;
            const char* a3 = a2 + kstep; const char* b3 = b2 + kstep;
            if (last && has_next) S.a_ready(nxt);
            if constexpr (SP2) {
            PG8_LDB(B0, 0, 0); PG8_LDB(B1, 0, 1); PG8_SCHED; PG8_LDA(At, 0, 0); PG8_STAGE(PG8_SA(1, 1), a1 + hstep, voffA);
            PG8_WAIT_V(8); PG8_WAIT_L(0); PG8_BAR; PG8_MMA(0, 0, At, B0); PG8_MMA(0, 1, At, B1); PG8_BAR; PG8_SCHED;
            PG8_LDA(At, 0, 1); PG8_STAGE(PG8_SB(0, 0), b2, voffB); PG8_STAGE(PG8_SB(0, 1), b2 + hstep, voffB); PG8_STAGE(PG8_SA(0, 0), a2, voffA);
            PG8_WAIT_V(8); PG8_WAIT_L(0); PG8_BAR; PG8_MMA(1, 0, At, B0); PG8_MMA(1, 1, At, B1); PG8_BAR; PG8_SCHED;
            PG8_LDB(B0, 1, 0); PG8_LDB(B1, 1, 1); PG8_SCHED; PG8_LDA(At, 1, 0); PG8_STAGE(PG8_SA(0, 1), a2 + hstep, voffA);
            PG8_WAIT_V(8); PG8_WAIT_L(0); PG8_BAR; PG8_MMA(0, 0, At, B0); PG8_MMA(0, 1, At, B1); PG8_BAR; PG8_SCHED;
            PG8_LDA(At, 1, 1); PG8_STAGE(PG8_SB(1, 0), b3, voffB); PG8_STAGE(PG8_SB(1, 1), b3 + hstep, voffB); PG8_STAGE(PG8_SA(1, 0), a3, voffA);
            PG8_WAIT_V(8); PG8_WAIT_L(0); PG8_BAR; PG8_MMA(1, 0, At, B0); PG8_MMA(1, 1, At, B1); PG8_BAR; PG8_SCHED;
            } else {
            PG8_LDB(B0, 0, 0); PG8_SCHED; PG8_LDA(At, 0, 0); PG8_STAGE(PG8_SA(1, 1), a1 + hstep, voffA);
            PG8_WAIT_L(8); PG8_BAR; PG8_WAIT_L(0); PG8_MMA(0, 0, At, B0); PG8_BAR; PG8_SCHED;
            PG8_LDB(B1, 0, 1); PG8_STAGE(PG8_SB(0, 0), b2, voffB);
            PG8_BAR; PG8_WAIT_L(0); PG8_MMA(0, 1, At, B1); PG8_BAR;
            PG8_LDA(At, 0, 1); PG8_STAGE(PG8_SA(0, 0), a2, voffA);
            PG8_BAR; PG8_WAIT_L(0); PG8_MMA(1, 0, At, B0); PG8_BAR; PG8_SCHED;
            PG8_STAGE(PG8_SB(0, 1), b2 + hstep, voffB);
            PG8_WAIT_V(6); PG8_BAR; PG8_MMA(1, 1, At, B1); PG8_BAR;
            PG8_LDB(B0, 1, 0); PG8_SCHED; PG8_LDA(At, 1, 0); PG8_STAGE(PG8_SA(0, 1), a2 + hstep, voffA);
            PG8_WAIT_L(8); PG8_BAR; PG8_WAIT_L(0); PG8_MMA(0, 0, At, B0); PG8_BAR; PG8_SCHED;
            PG8_LDB(B1, 1, 1); PG8_STAGE(PG8_SB(1, 0), b3, voffB);
            PG8_BAR; PG8_WAIT_L(0); PG8_MMA(0, 1, At, B1); PG8_BAR;
            PG8_LDA(At, 1, 1); PG8_STAGE(PG8_SA(1, 0), a3, voffA);
            PG8_BAR; PG8_WAIT_L(0); PG8_MMA(1, 0, At, B0); PG8_BAR; PG8_SCHED;
            PG8_STAGE(PG8_SB(1, 1), b3 + hstep, voffB);
            PG8_WAIT_V(6); PG8_BAR; PG8_MMA(1, 1, At, B1); PG8_BAR;
            }
        }
        if constexpr (ALIGN_EPI) { if (wr == 0) PG8_BAR; }
        if constexpr (!Epi::AFTER_DRAIN) { E(acc, cur, wr, wc, fr, fq); S.done(cur); }
        if (!has_next) break;
#pragma unroll
        for (int a = 0; a < 2; ++a)
#pragma unroll
            for (int b = 0; b < 2; ++b)
#pragma unroll
                for (int m = 0; m < 4; ++m)
#pragma unroll
                    for (int n = 0; n < 2; ++n) acc[a][b][m][n] = (f32x4){0.f, 0.f, 0.f, 0.f};
        cur = nxt; cA = nA; cB = nB; ++ui;
        if constexpr (ALIGN_EPI) { if (wr == 1) PG8_BAR; }
    }
    PG8_WAIT_V(0);
    if constexpr (!ALIGN_EPI) { if (wr == 0) PG8_BAR; }
    PG8_BAR;
    if constexpr (Epi::AFTER_DRAIN) { E.fused(acc, cur, wr, wc, fr, fq, lds, wid, lane); S.done(cur); }
#undef PG8_SA
#undef PG8_SB
#undef PG8_STAGE
#undef PG8_LDA
#undef PG8_LDB
#undef PG8_MMA
#undef PG8_WAIT_V
#undef PG8_WAIT_L
#undef PG8_BAR
#undef PG8_SCHED
}
}

typedef short bf16x8 __attribute__((ext_vector_type(8)));
typedef short s16x4 __attribute__((ext_vector_type(4)));
typedef float f32x16 __attribute__((ext_vector_type(16)));
#define MLAS __attribute__((address_space(3)))
constexpr int AK_STRIDE = 144, AV_STRIDE = 192, AK_BYTES = 32 * AK_STRIDE, AV_BYTES = 32 * AV_STRIDE, AW_BYTES = AK_BYTES + AV_BYTES;
constexpr int AB_OFF = 8 * AW_BYTES, AB_BYTES = 2048;
static_assert(AB_OFF + 8 * AB_BYTES <= 131072, "mixer LDS");
__device__ __forceinline__ int crow(int r, int hh) { return (r & 3) + 8 * (r >> 2) + 4 * hh; }
__device__ __forceinline__ unsigned cvtpk(float lo, float hi) { unsigned r; asm volatile("v_cvt_pk_bf16_f32 %0, %1, %2" : "=v"(r) : "v"(lo), "v"(hi)); return r; }
template <int OFF> __device__ __forceinline__ s16x4 tr_read(unsigned a) { s16x4 r; asm volatile("ds_read_b64_tr_b16 %0, %1 offset:%2" : "=&v"(r) : "v"(a), "i"(OFF) : "memory"); return r; }
__device__ __forceinline__ float xhalf_max(float v) { auto rr = __builtin_amdgcn_permlane32_swap(__float_as_uint(v), __float_as_uint(v), false, false); return fmaxf(__uint_as_float(rr[0]), __uint_as_float(rr[1])); }
__device__ __forceinline__ float xhalf_sum(float v) { auto rr = __builtin_amdgcn_permlane32_swap(__float_as_uint(v), __float_as_uint(v), false, false); return __uint_as_float(rr[0]) + __uint_as_float(rr[1]); }

struct TileRegs { u32x4 k[4], v[4]; };
__device__ __forceinline__ void tile_load(TileRegs& t, const bf16_t* Kb, const bf16_t* Vb, int tok0, int tstride, int lane) {
#pragma unroll
    for (int i = 0; i < 4; ++i) { const int id = lane + 64 * i, kk = id >> 3, ch = id & 7; const size_t off = (size_t)(tok0 + kk * tstride) * 64 + ch * 8;
        t.k[i] = *(const u32x4*)(Kb + off); t.v[i] = *(const u32x4*)(Vb + off); }
}
__device__ __forceinline__ void tile_store(const TileRegs& t, MLAS unsigned char* wl, int lane) {
#pragma unroll
    for (int i = 0; i < 4; ++i) { const int id = lane + 64 * i, kk = id >> 3, ch = id & 7;
        *(MLAS u32x4*)(wl + kk * AK_STRIDE + ch * 16) = t.k[i]; *(MLAS u32x4*)(wl + AK_BYTES + kk * AV_STRIDE + ch * 16) = t.v[i]; }
}
template <int ND> __device__ __forceinline__ void softmax_step(f32x16& p, float& m, float& l, f32x16 (&o)[ND]) {
    float tm = p[0];
#pragma unroll
    for (int r = 1; r < 16; ++r) tm = fmaxf(tm, p[r]);
    tm = xhalf_max(tm);
    const float mn = fmaxf(m, tm);
    if (__any(mn > m)) {
        const float al = __builtin_amdgcn_exp2f(m - mn);
        l *= al;
#pragma unroll
        for (int d = 0; d < ND; ++d) o[d] = o[d] * al;
        m = mn;
    }
    float ps = 0.f;
#pragma unroll
    for (int r = 0; r < 16; ++r) { p[r] = __builtin_amdgcn_exp2f(p[r] - m); ps += p[r]; }
    l += ps;
}
__device__ __forceinline__ void load_vfrags(bf16x8 (&vf)[2][2], unsigned vb) {
    const s16x4 a0 = tr_read<0>(vb), a1 = tr_read<1536>(vb), b0 = tr_read<64>(vb), b1 = tr_read<1536 + 64>(vb);
    const s16x4 c0 = tr_read<3072>(vb), c1 = tr_read<3072 + 1536>(vb), d0 = tr_read<3072 + 64>(vb), d1 = tr_read<3072 + 1536 + 64>(vb);
    asm volatile("s_waitcnt lgkmcnt(0)" ::: "memory"); __builtin_amdgcn_sched_barrier(0);
#define PK_(L, H) (bf16x8){L[0], L[1], L[2], L[3], H[0], H[1], H[2], H[3]}
    vf[0][0] = PK_(a0, a1); vf[0][1] = PK_(b0, b1); vf[1][0] = PK_(c0, c1); vf[1][1] = PK_(d0, d1);
#undef PK_
}
__device__ __forceinline__ void pv_step(const f32x16& p, const bf16x8 (&vf)[2][2], f32x16 (&o)[2]) {
#pragma unroll
    for (int s = 0; s < 2; ++s) {
        u32x4 w; w.x = cvtpk(p[8 * s + 0], p[8 * s + 1]); w.y = cvtpk(p[8 * s + 2], p[8 * s + 3]); w.z = cvtpk(p[8 * s + 4], p[8 * s + 5]); w.w = cvtpk(p[8 * s + 6], p[8 * s + 7]);
        const bf16x8 pf = __builtin_bit_cast(bf16x8, w);
#pragma unroll
        for (int d = 0; d < 2; ++d) o[d] = __builtin_amdgcn_mfma_f32_32x32x16_bf16(vf[s][d], pf, o[d], 0, 0, 0);
    }
}
__device__ __forceinline__ unsigned vfrag_base(MLAS unsigned char* wl, int lane) {
    const int hh = lane >> 5;
    return (unsigned)(uintptr_t)(wl + AK_BYTES) + (unsigned)((4 * hh + ((lane & 15) >> 2)) * AV_STRIDE + (16 * ((lane >> 4) & 1) + 4 * (lane & 3)) * 2);
}
__device__ __forceinline__ void store_o(bf16_t* crow_ptr, const f32x16 (&o)[2], int hh) {
#pragma unroll
    for (int d = 0; d < 2; ++d)
#pragma unroll
        for (int g = 0; g < 4; ++g) { u32x2 w; w.x = cvtpk(o[d][4 * g], o[d][4 * g + 1]); w.y = cvtpk(o[d][4 * g + 2], o[d][4 * g + 3]);
            *(u32x2*)(crow_ptr + 32 * d + 8 * g + 4 * hh) = w; }
}

__device__ __forceinline__ void attnA_wave(const bf16_t* P, const float* lamv, const float* subln, bf16_t* concat, int bh, int q0, MLAS unsigned char* wl, int lane) {
    const int hh = lane >> 5, b = bh >> 2, h = bh & 3;
    const bf16_t* Kb = P + 1 * TENS + (size_t)bh * SEQ * 64; const bf16_t* Vb = P + 2 * TENS + (size_t)bh * SEQ * 64;
    const bf16_t* qp = P + ((size_t)bh * SEQ + q0 + (lane & 31)) * 64 + hh * 8;
    bf16x8 qf[2][2];
#pragma unroll
    for (int c = 0; c < 2; ++c)
#pragma unroll
        for (int ds = 0; ds < 2; ++ds) qf[c][ds] = *(const bf16x8*)(qp + c * 32 + ds * 16);
    f32x16 o0[2], o1[2];
#pragma unroll
    for (int d = 0; d < 2; ++d)
#pragma unroll
        for (int r = 0; r < 16; ++r) { o0[d][r] = 0.f; o1[d][r] = 0.f; }
    float m0 = -1e30f, l0 = 0.f, m1 = -1e30f, l1 = 0.f;
    const unsigned vb = vfrag_base(wl, lane);
    const MLAS unsigned char* kfp = wl + (lane & 31) * AK_STRIDE + hh * 16;
    TileRegs tr; tile_load(tr, Kb, Vb, 0, 1, lane);
    for (int tt = 0; tt < SEQ / 32; ++tt) {
        tile_store(tr, wl, lane);
        if (tt + 1 < SEQ / 32) tile_load(tr, Kb, Vb, 32 * (tt + 1), 1, lane);
        asm volatile("s_waitcnt lgkmcnt(0)" ::: "memory");
        f32x16 p0, p1;
#pragma unroll
        for (int r = 0; r < 16; ++r) { p0[r] = 0.f; p1[r] = 0.f; }
#pragma unroll
        for (int ds = 0; ds < 2; ++ds) {
            const bf16x8 k0 = *(const MLAS bf16x8*)(kfp + ds * 32), k1 = *(const MLAS bf16x8*)(kfp + 64 + ds * 32);
            p0 = __builtin_amdgcn_mfma_f32_32x32x16_bf16(k0, qf[0][ds], p0, 0, 0, 0);
            p1 = __builtin_amdgcn_mfma_f32_32x32x16_bf16(k1, qf[1][ds], p1, 0, 0, 0);
        }
        bf16x8 vf[2][2]; load_vfrags(vf, vb);
        softmax_step<2>(p0, m0, l0, o0);
        pv_step(p0, vf, o0);
        softmax_step<2>(p1, m1, l1, o1);
        pv_step(p1, vf, o1);
        asm volatile("s_waitcnt lgkmcnt(0)" ::: "memory");
    }
    l0 = xhalf_sum(l0); l1 = xhalf_sum(l1);
    const float r0 = 1.f / l0, r1 = lamv[0] / l1;
    float ss = 0.f;
#pragma unroll
    for (int d = 0; d < 2; ++d)
#pragma unroll
        for (int r = 0; r < 16; ++r) { const float v = o0[d][r] * r0 - o1[d][r] * r1; o0[d][r] = v; ss += v * v; }
    ss = xhalf_sum(ss);
    const float rs = 1.0f / sqrtf(ss * (1.f / 64.f) + EPS) * lamv[1];
#pragma unroll
    for (int d = 0; d < 2; ++d)
#pragma unroll
        for (int g = 0; g < 4; ++g) { const f32x4 sg = *(const f32x4*)(subln + 32 * d + 8 * g + 4 * hh);
#pragma unroll
            for (int k = 0; k < 4; ++k) o0[d][4 * g + k] = o0[d][4 * g + k] * rs * sg[k]; }
    store_o(concat + ((size_t)b * SEQ + q0 + (lane & 31)) * DM + h * 64, o0, hh);
}

__device__ __forceinline__ void attnB_wave(const bf16_t* P, const float* rpb_h, bf16_t* concat, int bh, int i, int jh, MLAS unsigned char* wl, MLAS float* tb, int lane) {
    const int hh = lane >> 5, b = bh >> 2, h = bh & 3, j = 32 * jh + (lane & 31), s = i * 64 + j;
    const bf16_t* Kb = P + 4 * TENS + (size_t)bh * SEQ * 64; const bf16_t* Vb = P + 5 * TENS + (size_t)bh * SEQ * 64;
    const bf16_t* qp = P + 3 * TENS + ((size_t)bh * SEQ + s) * 64 + hh * 8;
    for (int idx = lane; idx < 15 * 32; idx += 64) { const int dr = idx >> 5, dc = idx & 31; tb[idx] = (dc < 31) ? rpb_h[dr * 31 + dc] * LOG2E : 0.f; }
    bf16x8 qf[4];
#pragma unroll
    for (int ds = 0; ds < 4; ++ds) qf[ds] = *(const bf16x8*)(qp + ds * 16);
    f32x16 o[2];
#pragma unroll
    for (int d = 0; d < 2; ++d)
#pragma unroll
        for (int r = 0; r < 16; ++r) o[d][r] = 0.f;
    float m = -1e30f, l = 0.f;
    const int rs = min(max(i - 4, 0), 24), cs = min(max(j - 8, 0), 48);
    const unsigned vb = vfrag_base(wl, lane);
    const MLAS unsigned char* kfp = wl + (lane & 31) * AK_STRIDE + hh * 16;
    TileRegs tr; tile_load(tr, Kb, Vb, rs * 64, 1, lane);
    for (int tt = 0; tt < 16; ++tt) {
        tile_store(tr, wl, lane);
        if (tt + 1 < 16) tile_load(tr, Kb, Vb, (rs + ((tt + 1) >> 1)) * 64 + 32 * ((tt + 1) & 1), 1, lane);
        asm volatile("s_waitcnt lgkmcnt(0)" ::: "memory");
        const int a = tt >> 1, ct = tt & 1, dr = rs + a - i + 7;
        f32x16 p;
#pragma unroll
        for (int r = 0; r < 16; ++r) p[r] = 0.f;
#pragma unroll
        for (int ds = 0; ds < 4; ++ds) { const bf16x8 kf = *(const MLAS bf16x8*)(kfp + ds * 32); p = __builtin_amdgcn_mfma_f32_32x32x16_bf16(kf, qf[ds], p, 0, 0, 0); }
        bf16x8 vf[2][2]; load_vfrags(vf, vb);
        const int c0 = 32 * ct + 4 * hh - cs;
        const MLAS float* tbr = tb + dr * 32 + (cs - j + 15);
#pragma unroll
        for (int r = 0; r < 16; ++r) { const int crel = c0 + (r & 3) + 8 * (r >> 2); const bool ok = (unsigned)crel < 16u;
            const float bias = tbr[ok ? crel : 0]; p[r] = ok ? p[r] + bias : -INFINITY; }
        softmax_step<2>(p, m, l, o);
        pv_step(p, vf, o);
        asm volatile("s_waitcnt lgkmcnt(0)" ::: "memory");
    }
    l = xhalf_sum(l);
    const float rl = 1.f / l;
#pragma unroll
    for (int d = 0; d < 2; ++d) o[d] = o[d] * rl;
    store_o(concat + ((size_t)b * SEQ + s) * DM + 256 + h * 64, o, hh);
}

__device__ __forceinline__ void attnD_wave(const bf16_t* P, bf16_t* concat, int bh, int u0, int rr, MLAS unsigned char* wl, int lane) {
    const int hh = lane >> 5, b = bh >> 2, h = bh & 3, qi = lane & 31, t = rr + 16 * (u0 + qi);
    const bf16_t* Kb = P + 7 * TENS + (size_t)bh * SEQ * 64; const bf16_t* Vb = P + 8 * TENS + (size_t)bh * SEQ * 64;
    const bf16_t* qp = P + 6 * TENS + ((size_t)bh * SEQ + t) * 64 + hh * 8;
    bf16x8 qf[4];
#pragma unroll
    for (int ds = 0; ds < 4; ++ds) qf[ds] = *(const bf16x8*)(qp + ds * 16);
    f32x16 o[2];
#pragma unroll
    for (int d = 0; d < 2; ++d)
#pragma unroll
        for (int r = 0; r < 16; ++r) o[d][r] = 0.f;
    float m = -1e30f, l = 0.f;
    const int k1lo = max(0, u0 / 8 - 2), k1hi = min(15, u0 / 8 + 5), k0lo = max(0, u0 / 2 - 2), k0hi = min(63, u0 / 2 + 17);
    const int n2 = 4, n1 = k1hi - k1lo + 1, n0 = k0hi - k0lo + 1, nt = n2 + n1 + n0;
    const int pq2 = u0 + qi, pq1 = (rr >> 2) + 4 * (u0 + qi), pq0 = t;
    const unsigned vb = vfrag_base(wl, lane);
    const MLAS unsigned char* kfp = wl + (lane & 31) * AK_STRIDE + hh * 16;
#define DTILE(tt, tok0, strd, pbase, pq) do { if ((tt) < n2) { tok0 = rr + 512 * (tt); strd = 16; pbase = 32 * (tt); pq = pq2; } \
        else if ((tt) < n2 + n1) { const int kt_ = k1lo + (tt) - n2; tok0 = (rr & 3) + 128 * kt_; strd = 4; pbase = 32 * kt_; pq = pq1; } \
        else { const int kt_ = k0lo + (tt) - n2 - n1; tok0 = 32 * kt_; strd = 1; pbase = 32 * kt_; pq = pq0; } } while (0)
    TileRegs tr; { int tok0, strd, pbase, pq; DTILE(0, tok0, strd, pbase, pq); (void)pbase; (void)pq; tile_load(tr, Kb, Vb, tok0, strd, lane); }
    for (int tt = 0; tt < nt; ++tt) {
        tile_store(tr, wl, lane);
        if (tt + 1 < nt) { int tok0, strd, pbase, pq; DTILE(tt + 1, tok0, strd, pbase, pq); (void)pbase; (void)pq; tile_load(tr, Kb, Vb, tok0, strd, lane); }
        asm volatile("s_waitcnt lgkmcnt(0)" ::: "memory");
        int tok0, strd, pbase, pq; DTILE(tt, tok0, strd, pbase, pq); (void)tok0; (void)strd;
        f32x16 p;
#pragma unroll
        for (int r = 0; r < 16; ++r) p[r] = 0.f;
#pragma unroll
        for (int ds = 0; ds < 4; ++ds) { const bf16x8 kf = *(const MLAS bf16x8*)(kfp + ds * 32); p = __builtin_amdgcn_mfma_f32_32x32x16_bf16(kf, qf[ds], p, 0, 0, 0); }
        bf16x8 vf[2][2]; load_vfrags(vf, vb);
        const int dl = pbase + 4 * hh - pq + 64;
#pragma unroll
        for (int r = 0; r < 16; ++r) { const bool ok = (unsigned)(dl + (r & 3) + 8 * (r >> 2)) <= 128u; p[r] = ok ? p[r] : -INFINITY; }
        softmax_step<2>(p, m, l, o);
        pv_step(p, vf, o);
        asm volatile("s_waitcnt lgkmcnt(0)" ::: "memory");
    }
#undef DTILE
    l = xhalf_sum(l);
    const float rl = 1.f / l;
#pragma unroll
    for (int d = 0; d < 2; ++d) o[d] = o[d] * rl;
    store_o(concat + ((size_t)b * SEQ + t) * DM + 768 + h * 64, o, hh);
}

__device__ __forceinline__ void conv_tile(const bf16_t* Z, const float* w_dw, const float* b_dw, const float* g_n, const float* b_n, bf16_t* concat, int tile, MLAS unsigned char* lds, int tid) {
    const int t0 = tile * 64, b = t0 >> 11, s0 = t0 & 2047;
    MLAS unsigned* slab = (MLAS unsigned*)lds;
    for (int id = tid; id < 94 * 32; id += 512) { const int rw = id >> 5, ch = id & 31, sp = s0 - 15 + rw;
        u32x4 v = {0u, 0u, 0u, 0u}; if (sp >= 0 && sp < SEQ) v = *(const u32x4*)(Z + ((size_t)b * SEQ + sp) * 256 + ch * 8);
        *(MLAS u32x4*)(slab + rw * 128 + ch * 4) = v; }
    __syncthreads();
    const int cp = tid & 127, tb = tid >> 7;
    unsigned zr[46];
#pragma unroll
    for (int k = 0; k < 46; ++k) zr[k] = slab[(16 * tb + k) * 128 + cp];
    float a0[16], a1[16];
    { const float bb0 = b_dw[2 * cp], bb1 = b_dw[2 * cp + 1];
#pragma unroll
      for (int t = 0; t < 16; ++t) { a0[t] = bb0; a1[t] = bb1; } }
#pragma unroll
    for (int k = 0; k < 31; ++k) { const float w0 = w_dw[k * 256 + 2 * cp], w1 = w_dw[k * 256 + 2 * cp + 1];
#pragma unroll
        for (int t = 0; t < 16; ++t) { a0[t] += bflo(zr[t + k]) * w0; a1[t] += bfhi(zr[t + k]) * w1; } }
    const float gn0 = g_n[2 * cp], gn1 = g_n[2 * cp + 1], bn0 = b_n[2 * cp], bn1 = b_n[2 * cp + 1];
#pragma unroll
    for (int t = 0; t < 16; ++t) {
        float sm = a0[t] + a1[t];
#pragma unroll
        for (int o = 1; o < 32; o <<= 1) sm += __shfl_xor(sm, o);
        const float mu = sm * (1.f / 64.f), d0 = a0[t] - mu, d1 = a1[t] - mu;
        float q = d0 * d0 + d1 * d1;
#pragma unroll
        for (int o = 1; o < 32; o <<= 1) q += __shfl_xor(q, o);
        const float rstd = 1.0f / sqrtf(q * (1.f / 64.f) + EPS);
        const float y0 = silu_f(d0 * rstd * gn0 + bn0), y1 = silu_f(d1 * rstd * gn1 + bn1);
        *(unsigned*)(concat + (size_t)(t0 + 16 * tb + t) * DM + 512 + 2 * cp) = cvtpk(y0, y1);
    }
    __syncthreads();
}

#define LAS __attribute__((address_space(3)))
#define GAS __attribute__((address_space(1)))
#define LDS_WAIT() asm volatile("s_waitcnt lgkmcnt(0)" ::: "memory")
#define VM_WAIT() asm volatile("s_waitcnt vmcnt(0)" ::: "memory")
constexpr int NWAVES = 8, NTHREADS = 512;
constexpr int RING_BYTES = 131072, LDSX_OFF = RING_BYTES, LDS_BYTES = 147456;
constexpr int LX_BAR = 0, LX_TSTART = 64, LX_PSTART = 256, LX_HIST = 512, LX_BASE = 640, LX_AE = 768, LX_ALR = 1280;
constexpr size_t OFF_WIN = 2 * MiB, OFF_WOUT = 14 * MiB, OFF_W1 = 18 * MiB, OFF_W2 = 146 * MiB;
constexpr int CW_BAR = 8192;
static_assert((CW_BAR + 3456) * 4 <= (int)CTL_BYTES, "ctl region");
constexpr float SCALE_A = 0.17677669529663687f * LOG2E, SCALE_64 = 0.125f * LOG2E;

#define XB_TMO      128
#define XB_XCNT(j)  (256  + 64 * (j))
#define XB_XSUB(j)  (1280 + 64 * (j))
#define XB_XGEN(j)  (2304 + 64 * (j))
#define XB_TOP      3328
#define XB_TOPGEN   3392
#define XCD_BAR_WORDS 3456
#define XB_SPIN_CAP (1u << 18)
__device__ __forceinline__ unsigned xb_ld(unsigned* p)              { return __hip_atomic_load(p, __ATOMIC_RELAXED, __HIP_MEMORY_SCOPE_AGENT); }
__device__ __forceinline__ unsigned xb_add(unsigned* p, unsigned v) { return __hip_atomic_fetch_add(p, v, __ATOMIC_RELAXED, __HIP_MEMORY_SCOPE_AGENT); }
__device__ __forceinline__ unsigned xb_xcc_id() { return (unsigned)__builtin_amdgcn_s_getreg((3 << 11) | 20) & 0xFu; }
#define XB_SPIN(cond, bar) do { unsigned _sp = 0; while (cond) { __builtin_amdgcn_s_sleep(1); \
    if ((++_sp & 255u) == 0u) { if (xb_ld(&(bar)[XB_TMO])) break; if (_sp > XB_SPIN_CAP) { atomicAdd(&(bar)[XB_TMO], 1u); break; } } } } while (0)
struct XcdBarrier { unsigned* bar; unsigned x; volatile LAS unsigned* st; };
__device__ __forceinline__ XcdBarrier xcd_barrier_post(unsigned* bar, volatile LAS unsigned* st) {
    XcdBarrier b; b.bar = bar; b.x = xb_xcc_id(); b.st = st;
    if (threadIdx.x == 0) (void)xb_add(&bar[XB_XCNT(b.x)], 1u);
    return b;
}
__device__ __forceinline__ void xcd_barrier_complete(unsigned* bar, unsigned x, unsigned& nloc, unsigned& nx) {
    const unsigned G = gridDim.x * gridDim.y * gridDim.z;
    unsigned sum, cnt, mine, sp = 0u;
    for (;;) {
        sum = 0u; cnt = 0u; mine = 0u;
#pragma unroll
        for (unsigned j = 0; j < 16; ++j) { const unsigned c = xb_ld(&bar[XB_XCNT(j)]); sum += c; cnt += (c > 0u) ? 1u : 0u; mine = (j == x) ? c : mine; }
        if (sum == G) break;
        __builtin_amdgcn_s_sleep(1);
        if ((++sp & 255u) == 0u) { if (xb_ld(&bar[XB_TMO])) break; if (sp > XB_SPIN_CAP) { atomicAdd(&bar[XB_TMO], 1u); break; } }
    }
    nloc = mine > 0u ? mine : 1u; nx = cnt > 0u ? cnt : 1u;
}
__device__ __forceinline__ void xcd_barrier(const XcdBarrier& b) {
    asm volatile("s_waitcnt vmcnt(0)" ::: "memory");
    __syncthreads();
    if (threadIdx.x == 0) {
        unsigned* bar = b.bar;
        __builtin_amdgcn_s_waitcnt(0);
        unsigned nloc = b.st[0], nx = b.st[1];
        if (nloc == 0u) { xcd_barrier_complete(bar, b.x, nloc, nx); b.st[0] = nloc; b.st[1] = nx; }
        const unsigned old = xb_add(&bar[XB_XSUB(b.x)], 1u);
        const unsigned gen = old / nloc;
        if (old + 1u == (gen + 1u) * nloc) {
            __builtin_amdgcn_fence(__ATOMIC_RELEASE, "agent");
            asm volatile("s_waitcnt vmcnt(0)" ::: "memory");
            const unsigned og = xb_add(&bar[XB_TOP], 1u);
            const unsigned tg = og / nx;
            if (og + 1u == (tg + 1u) * nx) xb_add(&bar[XB_TOPGEN], 1u);
            else XB_SPIN(xb_ld(&bar[XB_TOPGEN]) == tg, bar);
            __builtin_amdgcn_fence(__ATOMIC_ACQUIRE, "agent");
            xb_add(&bar[XB_XGEN(b.x)], 1u);
            asm volatile("s_waitcnt vmcnt(0)" ::: "memory");
        } else {
            XB_SPIN(xb_ld(&bar[XB_XGEN(b.x)]) == gen, bar);
            __builtin_amdgcn_fence(__ATOMIC_ACQUIRE, "agent");
            asm volatile("s_waitcnt vmcnt(0)" ::: "memory");
        }
    }
    __syncthreads();
}

__device__ __forceinline__ u32x4 pack8(pg8::f32x4 a, pg8::f32x4 b) {
    u32x4 w; w.x = pg8::cvt_pk_bf16(a[0], a[1]); w.y = pg8::cvt_pk_bf16(a[2], a[3]); w.z = pg8::cvt_pk_bf16(b[0], b[1]); w.w = pg8::cvt_pk_bf16(b[2], b[3]); return w;
}
struct EpiProj {
    static constexpr bool PERM = true, AFTER_DRAIN = false;
    bf16_t* P; const float* rot;
    __device__ __forceinline__ void operator()(const pg8::f32x4 (&acc)[2][2][4][2], const pg8::Unit& u, int wr, int wc, int fr, int fq) const {
        const int pn = u.pn;
        const float* cos64 = rot; const float* sin64 = rot + 2048 * 32; const float* cos32 = rot + 2 * 2048 * 32; const float* sin32 = cos32 + 2048 * 16;
#pragma unroll
        for (int ai = 0; ai < 2; ++ai)
#pragma unroll
            for (int m = 0; m < 4; ++m) {
                const int row = u.pm * 256 + ai * 128 + wr * 64 + m * 16 + fr, b = row >> 11, s = row & 2047;
                if (pn == 6 || pn == 7) {
                    const int ch = (pn - 6) * 128 + wc * 32 + 8 * fq;
                    pg8::f32x4 z0, z1;
#pragma unroll
                    for (int k = 0; k < 4; ++k) { z0[k] = acc[ai][0][m][0][k] / (1.f + __expf(-acc[ai][1][m][0][k])); z1[k] = acc[ai][0][m][1][k] / (1.f + __expf(-acc[ai][1][m][1][k])); }
                    *(u32x4*)(P + 9 * TENS + (size_t)row * 256 + ch) = pack8(z0, z1);
                } else {
#pragma unroll
                    for (int bj = 0; bj < 2; ++bj) {
                        const int c8 = bj * 128 + wc * 32 + 8 * fq, h = c8 >> 6, e = c8 & 63;
                        pg8::f32x4 v0 = acc[ai][bj][m][0], v1 = acc[ai][bj][m][1];
                        int tens = pn;
                        if (pn <= 1 || pn == 8 || pn == 9) {
                            pg8::f32x4 cs, sn;
                            if (pn <= 1) { const int i0 = (e & 31) >> 1; cs = *(const pg8::f32x4*)(cos32 + s * 16 + i0); sn = *(const pg8::f32x4*)(sin32 + s * 16 + i0); }
                            else { const int i0 = e >> 1; cs = *(const pg8::f32x4*)(cos64 + s * 32 + i0); sn = *(const pg8::f32x4*)(sin64 + s * 32 + i0); tens = pn - 2; }
                            const pg8::f32x4 a = v0, c = v1;
                            v0[0] = a[0] * cs[0] - a[1] * sn[0]; v0[1] = a[1] * cs[0] + a[0] * sn[0]; v0[2] = a[2] * cs[1] - a[3] * sn[1]; v0[3] = a[3] * cs[1] + a[2] * sn[1];
                            v1[0] = c[0] * cs[2] - c[1] * sn[2]; v1[1] = c[1] * cs[2] + c[0] * sn[2]; v1[2] = c[2] * cs[3] - c[3] * sn[3]; v1[3] = c[3] * cs[3] + c[2] * sn[3];
                        } else if (pn == 10) tens = 8;
                        const float sc = (pn == 0) ? SCALE_A : ((pn == 3 || pn == 8) ? SCALE_64 : 1.f);
                        v0 = v0 * sc; v1 = v1 * sc;
                        *(u32x4*)(P + (size_t)tens * TENS + (((size_t)b * 4 + h) * SEQ + s) * 64 + e) = pack8(v0, v1);
                    }
                }
            }
    }
};
struct EpiOut {
    static constexpr bool PERM = true, AFTER_DRAIN = false;
    const float* xin; const float* modl; float* out;
    __device__ __forceinline__ void operator()(const pg8::f32x4 (&acc)[2][2][4][2], const pg8::Unit& u, int wr, int wc, int fr, int fq) const {
#pragma unroll
        for (int ai = 0; ai < 2; ++ai)
#pragma unroll
            for (int m = 0; m < 4; ++m) {
                const int row = u.pm * 256 + ai * 128 + wr * 64 + m * 16 + fr, b = row >> 11;
#pragma unroll
                for (int bj = 0; bj < 2; ++bj) {
                    const int col = u.pn * 256 + bj * 128 + wc * 32 + 8 * fq;
                    const float* gp = modl + (size_t)b * 6144 + 2048 + col; const float* xp = xin + (size_t)row * DM + col; float* op = out + (size_t)row * DM + col;
                    *(pg8::f32x4*)op = *(const pg8::f32x4*)xp + *(const pg8::f32x4*)gp * acc[ai][bj][m][0];
                    *(pg8::f32x4*)(op + 4) = *(const pg8::f32x4*)(xp + 4) + *(const pg8::f32x4*)(gp + 4) * acc[ai][bj][m][1];
                }
            }
    }
};
struct EpiGUm {
    static constexpr bool PERM = true, AFTER_DRAIN = false;
    bf16_t* hdn;
    __device__ __forceinline__ void operator()(const pg8::f32x4 (&acc)[2][2][4][2], const pg8::Unit& u, int wr, int wc, int fr, int fq) const {
#pragma unroll
        for (int ai = 0; ai < 2; ++ai)
#pragma unroll
            for (int m = 0; m < 4; ++m) {
                const int row = u.pm * 256 + ai * 128 + wr * 64 + m * 16 + fr, col = (u.pn & 3) * 128 + wc * 32 + 8 * fq;
                pg8::f32x4 z0, z1;
#pragma unroll
                for (int k = 0; k < 4; ++k) { const float g0 = acc[ai][0][m][0][k], g1 = acc[ai][0][m][1][k];
                    z0[k] = g0 / (1.f + __expf(-g0)) * acc[ai][1][m][0][k]; z1[k] = g1 / (1.f + __expf(-g1)) * acc[ai][1][m][1][k]; }
                *(u32x4*)(hdn + (size_t)row * DE + col) = pack8(z0, z1);
            }
    }
};
struct EpiYm {
    static constexpr bool PERM = true, AFTER_DRAIN = false;
    bf16_t* y;
    __device__ __forceinline__ void operator()(const pg8::f32x4 (&acc)[2][2][4][2], const pg8::Unit& u, int wr, int wc, int fr, int fq) const {
#pragma unroll
        for (int ai = 0; ai < 2; ++ai)
#pragma unroll
            for (int m = 0; m < 4; ++m) {
                const int row = u.pm * 256 + ai * 128 + wr * 64 + m * 16 + fr;
#pragma unroll
                for (int bj = 0; bj < 2; ++bj) { const int col = (u.pn & 3) * 256 + bj * 128 + wc * 32 + 8 * fq;
                    *(u32x4*)(y + (size_t)row * DM + col) = pack8(acc[ai][bj][m][0], acc[ai][bj][m][1]); }
            }
    }
};
struct MoeOrder {
    const LAS int* tstart; int G, c;
    __device__ __forceinline__ bool next(int i, pg8::Unit& u) const {
        const int L = i * G + c, ntile = tstart[NE];
        if (L >= ntile * 4) return false;
        const int tl = L >> 2; int e = 0;
#pragma unroll 1
        for (int k = 1; k < NE; ++k) e += (tstart[k] <= tl) ? 1 : 0;
        u.pm = tl; u.pn = e * 4 + (L & 3); return true;
    }
    __device__ __forceinline__ void a_ready(const pg8::Unit&) const {}
    __device__ __forceinline__ void done(const pg8::Unit&) const {}
};

template <class RM>
__device__ __forceinline__ void transpose_item(const float* W, int K, int N, bf16_t* WT, RM rm, LAS float* scr, int item, int lane) {
    const int nblk = N / 32, kb = item / nblk, nb = item % nblk, k0 = 64 * kb, n0 = 32 * nb;
#pragma unroll 8
    for (int i = 0; i < 32; ++i) { const int kk = 2 * i + (lane >> 5); scr[kk * 33 + (lane & 31)] = W[(size_t)(k0 + kk) * N + n0 + (lane & 31)]; }
    LDS_WAIT(); asm volatile("" ::: "memory");
    const int c = lane & 7;
#pragma unroll
    for (int j = 0; j < 4; ++j) { const int n = (lane >> 3) + 8 * j; const LAS float* s = scr + (8 * c) * 33 + n;
        u32x4 o; o.x = pk2(s[0 * 33], s[1 * 33]); o.y = pk2(s[2 * 33], s[3 * 33]); o.z = pk2(s[4 * 33], s[5 * 33]); o.w = pk2(s[6 * 33], s[7 * 33]);
        *(u32x4*)(WT + (size_t)rm(n0 + n) * K + k0 + 8 * c) = o; }
    LDS_WAIT(); asm volatile("" ::: "memory");
}
struct RmId { __device__ __forceinline__ int operator()(int n) const { return n; } };
struct RmGate { int up; __device__ __forceinline__ int operator()(int n) const { return (n >> 7) * 256 + up * 128 + (n & 127); } };
struct RmIn { __device__ __forceinline__ int operator()(int n) const {
    if (n < 512) { const int pn = n >> 8, r = n & 255, h = r >> 6, e = r & 63, cm = e >> 5, el = e & 31, i = el & 15, odd = el >> 4; return pn * 256 + h * 64 + cm * 32 + 2 * i + odd; }
    if (n < 1536) return n;
    if (n < 1792) { const int ch = n - 1536; return (6 + (ch >> 7)) * 256 + (ch & 127); }
    if (n < 2048) { const int ch = n - 1792; return (6 + (ch >> 7)) * 256 + 128 + (ch & 127); }
    if (n < 2560) { const int q = n - 2048, pn = 8 + (q >> 8), r = q & 255, h = r >> 6, e = r & 63, i = e & 31, odd = e >> 5; return pn * 256 + h * 64 + 2 * i + odd; }
    return n; } };

struct Args { const float* in[21]; float* out; unsigned char* ws; int ph_lo, ph_hi; };
constexpr int PH_PRO = 0, PH_NORM = 1, PH_L0 = 2, NPL = 8, NPH = PH_L0 + NPL * DEPTH;

typedef const __attribute__((address_space(4))) Args* KArgs;
__device__ __forceinline__ KArgs kargs() { KArgs p = (KArgs)__builtin_amdgcn_kernarg_segment_ptr(); asm volatile("" : "+s"(p)); return p; }
#define PH_BEGIN KArgs ka = kargs(); int tid = threadIdx.x; asm volatile("" : "+v"(tid)); const int lane = tid & 63, wave = __builtin_amdgcn_readfirstlane(tid >> 6); \
    unsigned char* ws = ka->ws; const int gw = bx * NWAVES + wave, NGW = G * NWAVES; (void)lane; (void)gw; (void)NGW; (void)ws; \
    LAS unsigned char* lds = (LAS unsigned char*)lds_raw; LAS unsigned char* ldx = lds + LDSX_OFF; (void)ldx;
#define WS_PTRS unsigned* ctl = (unsigned*)(ws + OFF_CTL); float* mod = (float*)(ws + OFF_MOD); float* rot = (float*)(ws + OFF_ROT); float* lamv = (float*)(ws + OFF_LAM); \
    int* eid = (int*)(ws + OFF_ROUTE); float* gate = (float*)(ws + OFF_ROUTE + 128 * 1024); int* rank = (int*)(ws + OFF_ROUTE + 256 * 1024); int* tokslot = (int*)(ws + OFF_ROUTE + 384 * 1024); \
    float* X1 = (float*)(ws + OFF_X1); float* X2 = (float*)(ws + OFF_X2); bf16_t* H = (bf16_t*)(ws + OFF_H); \
    bf16_t* P = (bf16_t*)(ws + OFF_P); bf16_t* XB = P; bf16_t* Y = P; bf16_t* CC = (bf16_t*)(ws + OFF_C); bf16_t* HDN = CC; \
    bf16_t* WIN = (bf16_t*)(ws + OFF_WIN); bf16_t* WOUT = (bf16_t*)(ws + OFF_WOUT); bf16_t* W1 = (bf16_t*)(ws + OFF_W1); bf16_t* W2 = (bf16_t*)(ws + OFF_W2); \
    const float* modl = mod + (size_t)l * BATCH * 6144; const float* xin = (l == 0) ? ka->in[0] : X2; unsigned* gcnt = ctl + CW_CNT + l * 64; \
    (void)ctl; (void)mod; (void)rot; (void)lamv; (void)eid; (void)gate; (void)rank; (void)tokslot; (void)X1; (void)X2; (void)H; (void)P; (void)XB; (void)Y; (void)CC; (void)HDN; \
    (void)WIN; (void)WOUT; (void)W1; (void)W2; (void)modl; (void)xin; (void)gcnt;

__global__ void __launch_bounds__(NTHREADS, 2) mk_fwd(Args args) {
    extern __shared__ __attribute__((aligned(16))) unsigned char lds_raw[];
    const int G = gridDim.x, bx = blockIdx.x;
    const int lo = args.ph_lo, hi = args.ph_hi;
    XcdBarrier bar;
    {
        LAS unsigned char* ldx0 = (LAS unsigned char*)lds_raw + LDSX_OFF;
        if (threadIdx.x < 16) ((LAS unsigned*)ldx0)[threadIdx.x] = 0u;
        __syncthreads();
        unsigned* ctl0 = (unsigned*)(args.ws + OFF_CTL);
        bar.bar = ctl0 + CW_BAR; bar.x = 0; bar.st = (volatile LAS unsigned*)(ldx0 + LX_BAR);
        if (hi - lo > 1) bar = xcd_barrier_post(ctl0 + CW_BAR, (volatile LAS unsigned*)(ldx0 + LX_BAR));
    }
#define IN(k) (lo <= (k) && (k) < hi)
#define SEAM(k) do { if (IN(k) && IN((k) + 1)) xcd_barrier(bar); } while (0)

    if (IN(PH_PRO)) {
        const int l = 0; PH_BEGIN WS_PTRS
        {
            float* cos64 = rot; float* sin64 = rot + 2048 * 32; float* cos32 = rot + 2 * 2048 * 32; float* sin32 = cos32 + 2048 * 16;
            for (int idx = bx * NTHREADS + tid; idx < 2048 * 32; idx += G * NTHREADS) {
                const int pos = idx >> 5, i = idx & 31;
                { const double inv = pow(10000.0, -(double)i / 32.0), a = (double)pos * inv; cos64[idx] = (float)cos(a); sin64[idx] = (float)sin(a); }
                if (i < 16) { const double inv = pow(10000.0, -(double)i / 16.0), a = (double)pos * inv; cos32[pos * 16 + i] = (float)cos(a); sin32[pos * 16 + i] = (float)sin(a); }
            }
            if (bx == 0 && tid < DEPTH) {
                const float* lp = ka->in[7] + tid * 4 * 32; float s01 = 0.f, s23 = 0.f;
                for (int e = 0; e < 32; ++e) { s01 += lp[e] * lp[32 + e]; s23 += lp[64 + e] * lp[96 + e]; }
                const float lam_init = 0.8f - 0.6f * expf(-0.3f * (float)tid);
                lamv[2 * tid] = expf(s01) - expf(s23) + lam_init; lamv[2 * tid + 1] = 1.f - lam_init;
            }
        }
        {
            LAS float* ca = (LAS float*)lds; LAS float* red = (LAS float*)(lds + 32768);
            const float* c = ka->in[1]; const float* w_ada = ka->in[2]; const float* b_ada = ka->in[3];
            for (int unit = bx; unit < DEPTH * 96; unit += G) {
                const int l = unit / 96, n0 = (unit % 96) * 64;
                __syncthreads();
                for (int i = tid; i < BATCH * DM; i += NTHREADS) ca[i] = silu_f(c[i]);
                __syncthreads();
                float acc[BATCH];
#pragma unroll
                for (int b = 0; b < BATCH; ++b) acc[b] = 0.f;
                const float* wp = w_ada + ((size_t)l * DM + wave * 128) * 6144 + n0 + lane;
                for (int dd = 0; dd < 128; ++dd) { const float w = wp[(size_t)dd * 6144];
#pragma unroll
                    for (int b = 0; b < BATCH; ++b) acc[b] += ca[b * DM + wave * 128 + dd] * w; }
#pragma unroll
                for (int b = 0; b < BATCH; ++b) red[(wave * BATCH + b) * 64 + lane] = acc[b];
                __syncthreads();
                { const int b = tid >> 6; float s = b_ada[l * 6144 + n0 + lane];
#pragma unroll
                  for (int k = 0; k < NWAVES; ++k) s += red[(k * BATCH + b) * 64 + lane];
                  mod[((size_t)l * BATCH + b) * 6144 + n0 + lane] = s; }
            }
            __syncthreads();
        }
        {
            LAS float* scr = (LAS float*)(lds + wave * 16384);
            constexpr int I_IN = 16 * 88, I_OUT = 16 * 32, I_G = 32 * 256, I_D = 32 * 256, I_L = I_IN + I_OUT + 2 * I_G + I_D;
            for (int it = gw; it < DEPTH * I_L; it += NGW) {
                const int l = it / I_L; int r = it % I_L;
                if (r < I_IN) { transpose_item(ka->in[6] + (size_t)l * DM * P_IN, DM, P_IN, WIN + (size_t)l * P_IN * DM, RmIn{}, scr, r, lane); continue; } r -= I_IN;
                if (r < I_OUT) { transpose_item(ka->in[14] + (size_t)l * DM * DM, DM, DM, WOUT + (size_t)l * DM * DM, RmId{}, scr, r, lane); continue; } r -= I_OUT;
                if (r < I_G) { const int e = r >> 8; transpose_item(ka->in[17] + ((size_t)l * NE + e) * DM * DE, DM, DE, W1 + ((size_t)l * NE + e) * 1024 * DM, RmGate{0}, scr, r & 255, lane); continue; } r -= I_G;
                if (r < I_G) { const int e = r >> 8; transpose_item(ka->in[18] + ((size_t)l * NE + e) * DM * DE, DM, DE, W1 + ((size_t)l * NE + e) * 1024 * DM, RmGate{1}, scr, r & 255, lane); continue; } r -= I_G;
                { const int e = r >> 8; transpose_item(ka->in[19] + ((size_t)l * NE + e) * DE * DM, DE, DM, W2 + ((size_t)l * NE + e) * DM * DE, RmId{}, scr, r & 255, lane); }
            }
        }
    }
    SEAM(PH_PRO);
    if (IN(PH_NORM)) {
        const int l = 0; PH_BEGIN WS_PTRS
        const float* x = ka->in[0];
        for (int row = gw; row < T; row += NGW) {
            f32x4 v[4]; load_row(x + (size_t)row * DM, lane, v);
            const float* m = mod + (size_t)(row >> 11) * 6144;
            norm_mod_row(v, ka->in[4], m + 1024, m, lane);
            store_row_bf16(H + (size_t)row * DM, lane, v);
        }
    }
    SEAM(PH_NORM);
    for (int l = 0; l < DEPTH; ++l) {
        const int pb = PH_L0 + NPL * l;
        if (IN(pb + 0)) {
            PH_BEGIN WS_PTRS
            pg8::Gemm g{H, WIN + (size_t)l * P_IN * DM, T, P_IN, DM}; pg8::StaticOrder S; S.init(T, P_IN, G, bx);
            EpiProj E{P, rot};
            pg8::gemm_phase<EpiProj, pg8::StaticOrder, true, true>(lds, g, S, E);
        }
        SEAM(pb + 0);
        if (IN(pb + 1)) {
            PH_BEGIN WS_PTRS
            MLAS unsigned char* wl = lds + wave * AW_BYTES;
            for (int u = bx; u < 256; u += G) {
                attnA_wave(P, lamv + 2 * l, ka->in[8] + l * 64, CC, u >> 3, (u & 7) * 256 + wave * 32, wl, lane);
                attnB_wave(P, ka->in[9] + ((size_t)l * 4 + ((u >> 3) & 3)) * 15 * 31, CC, u >> 3, 4 * (u & 7) + (wave >> 1), wave & 1, wl, (MLAS float*)(lds + AB_OFF + wave * AB_BYTES), lane);
                attnD_wave(P, CC, u >> 3, 32 * ((u >> 1) & 3), 8 * (u & 1) + wave, wl, lane);
            }
            __syncthreads();
            for (int u = bx; u < 256; u += G)
                conv_tile(P + 9 * TENS, ka->in[10] + l * 31 * 256, ka->in[11] + l * 256, ka->in[12] + l * 256, ka->in[13] + l * 256, CC, u, lds, tid);
        }
        SEAM(pb + 1);
        if (IN(pb + 2)) {
            PH_BEGIN WS_PTRS
            pg8::Gemm g{CC, WOUT + (size_t)l * DM * DM, T, DM, DM}; pg8::StaticOrder S; S.init(T, DM, G, bx);
            EpiOut E{xin, modl, X1};
            pg8::gemm_phase<EpiOut, pg8::StaticOrder, true, true>(lds, g, S, E);
        }
        SEAM(pb + 2);
        if (IN(pb + 3)) {
            PH_BEGIN WS_PTRS
            LAS int* hist = (LAS int*)(ldx + LX_HIST); LAS int* basee = (LAS int*)(ldx + LX_BASE); LAS int* a_e = (LAS int*)(ldx + LX_AE); LAS int* a_lr = (LAS int*)(ldx + LX_ALR);
            const float* g2 = ka->in[5] + l * DM; const float* w_rg = ka->in[15] + (size_t)l * DM * 4; const float* w_re = ka->in[16] + (size_t)l * 4 * DM * 8;
            for (int chunk = bx; chunk < T / 64; chunk += G) {
                __syncthreads();
                if (tid < NE) hist[tid] = 0;
                __syncthreads();
                for (int it = 0; it < 8; ++it) {
                    const int lr = wave * 8 + it, row = chunk * 64 + lr, b = row >> 11;
                    f32x4 v[4]; load_row(X1 + (size_t)row * DM, lane, v);
                    const float* m = modl + (size_t)b * 6144;
                    norm_mod_row(v, g2, m + 4 * 1024, m + 3 * 1024, lane);
                    store_row_bf16(H + (size_t)row * DM, lane, v);
                    float lg[4] = {0.f, 0.f, 0.f, 0.f};
#pragma unroll
                    for (int j = 0; j < 4; ++j)
#pragma unroll
                        for (int k = 0; k < 4; ++k) { const f32x4 w = *(const f32x4*)(w_rg + (size_t)(256 * j + 4 * lane + k) * 4); const float xv = v[j][k];
                            lg[0] += xv * w.x; lg[1] += xv * w.y; lg[2] += xv * w.z; lg[3] += xv * w.w; }
#pragma unroll
                    for (int g = 0; g < 4; ++g) lg[g] = wave_sum(lg[g]);
                    int grp = 0; float best = lg[0];
#pragma unroll
                    for (int g = 1; g < 4; ++g) if (lg[g] > best) { best = lg[g]; grp = g; }
                    float den = 0.f;
#pragma unroll
                    for (int g = 0; g < 4; ++g) den += expf(lg[g] - best);
                    const float p_grp = 1.f / den;
                    float le[8];
#pragma unroll
                    for (int e = 0; e < 8; ++e) le[e] = 0.f;
                    const float* wre = w_re + (size_t)grp * DM * 8;
#pragma unroll
                    for (int j = 0; j < 4; ++j)
#pragma unroll
                        for (int k = 0; k < 4; ++k) { const float* wp = wre + (size_t)(256 * j + 4 * lane + k) * 8; const f32x4 w0 = *(const f32x4*)wp, w1 = *(const f32x4*)(wp + 4); const float xv = v[j][k];
                            le[0] += xv * w0.x; le[1] += xv * w0.y; le[2] += xv * w0.z; le[3] += xv * w0.w; le[4] += xv * w1.x; le[5] += xv * w1.y; le[6] += xv * w1.z; le[7] += xv * w1.w; }
#pragma unroll
                    for (int e = 0; e < 8; ++e) le[e] = wave_sum(le[e]);
                    int i0 = 0; float v0 = le[0];
#pragma unroll
                    for (int e = 1; e < 8; ++e) if (le[e] > v0) { v0 = le[e]; i0 = e; }
                    int i1 = -1; float v1 = -3.0e38f;
#pragma unroll
                    for (int e = 0; e < 8; ++e) if (e != i0 && le[e] > v1) { v1 = le[e]; i1 = e; }
                    const float e1 = expf(v1 - v0), gt0 = p_grp / (1.f + e1), gt1 = p_grp * e1 / (1.f + e1);
                    if (lane == 0) {
                        const int ea = grp * 8 + i0, eb = grp * 8 + i1;
                        eid[row * 2] = ea; eid[row * 2 + 1] = eb; gate[row * 2] = gt0; gate[row * 2 + 1] = gt1;
                        a_e[lr * 2] = ea; a_e[lr * 2 + 1] = eb;
                        a_lr[lr * 2] = __hip_atomic_fetch_add(&hist[ea], 1, __ATOMIC_RELAXED, __HIP_MEMORY_SCOPE_WORKGROUP);
                        a_lr[lr * 2 + 1] = __hip_atomic_fetch_add(&hist[eb], 1, __ATOMIC_RELAXED, __HIP_MEMORY_SCOPE_WORKGROUP);
                    }
                }
                __syncthreads();
                if (tid < NE) basee[tid] = (int)atomicAdd(&gcnt[tid], (unsigned)hist[tid]);
                __syncthreads();
                if (tid < 128) rank[chunk * 128 + tid] = basee[a_e[tid]] + a_lr[tid];
            }
        }
        SEAM(pb + 3);
        if (IN(pb + 4)) {
            PH_BEGIN WS_PTRS
            LAS int* pstart = (LAS int*)(ldx + LX_PSTART);
            __syncthreads();
            if (tid == 0) { int s = 0; for (int e = 0; e < NE; ++e) { pstart[e] = s; s += ((int)gcnt[e] + 255) / 256 * 256; } }
            __syncthreads();
            for (int row = gw; row < T; row += NGW) {
                const u32x4* src = (const u32x4*)(H + (size_t)row * DM);
                const u32x4 a = src[lane], b = src[64 + lane];
#pragma unroll
                for (int k = 0; k < 2; ++k) {
                    const int slot = pstart[eid[row * 2 + k]] + rank[row * 2 + k];
                    u32x4* dst = (u32x4*)(XB + (size_t)slot * DM); dst[lane] = a; dst[64 + lane] = b;
                    if (lane == 0) tokslot[row * 2 + k] = slot;
                }
            }
        }
        SEAM(pb + 4);
        if (IN(pb + 5) || IN(pb + 6)) {
            PH_BEGIN WS_PTRS
            LAS int* tstart = (LAS int*)(ldx + LX_TSTART);
            __syncthreads();
            if (tid == 0) { int s = 0; for (int e = 0; e < NE; ++e) { tstart[e] = s; s += ((int)gcnt[e] + 255) / 256; } tstart[NE] = s; }
            __syncthreads();
        }
        if (IN(pb + 5)) {
            PH_BEGIN WS_PTRS
            pg8::Gemm g{XB, W1 + (size_t)l * NE * 1024 * DM, NSLOT, NE * 1024, DM}; MoeOrder S{(const LAS int*)(ldx + LX_TSTART), G, bx};
            EpiGUm E{HDN};
            pg8::gemm_phase<EpiGUm, MoeOrder, true, true>(lds, g, S, E);
        }
        SEAM(pb + 5);
        if (IN(pb + 6)) {
            PH_BEGIN WS_PTRS
            pg8::Gemm g{HDN, W2 + (size_t)l * NE * DM * DE, NSLOT, NE * 1024, DE}; MoeOrder S{(const LAS int*)(ldx + LX_TSTART), G, bx};
            EpiYm E{Y};
            pg8::gemm_phase<EpiYm, MoeOrder, true, true>(lds, g, S, E);
        }
        SEAM(pb + 6);
        if (IN(pb + 7)) {
            PH_BEGIN WS_PTRS
            const bool last = (l + 1 == DEPTH);
            const float* gnext = last ? ka->in[20] : ka->in[4] + (l + 1) * DM; const float* mnext = mod + (size_t)(l + 1) * BATCH * 6144;
            for (int row = gw; row < T; row += NGW) {
                const int b = row >> 11;
                f32x4 v[4], y0[4], y1[4]; load_row(X1 + (size_t)row * DM, lane, v);
                load_row_bf16(Y + (size_t)tokslot[row * 2] * DM, lane, y0); load_row_bf16(Y + (size_t)tokslot[row * 2 + 1] * DM, lane, y1);
                const float g0 = gate[row * 2], g1 = gate[row * 2 + 1];
                const float* gt2 = modl + (size_t)b * 6144 + 5 * 1024;
#pragma unroll
                for (int j = 0; j < 4; ++j) { const f32x4 gg = *(const f32x4*)(gt2 + 256 * j + 4 * lane); v[j] = v[j] + gg * (y0[j] * g0 + y1[j] * g1); }
                if (last) { norm_mod_row(v, gnext, nullptr, nullptr, lane); store_row_f32(ka->out + (size_t)row * DM, lane, v); }
                else { store_row_f32(X2 + (size_t)row * DM, lane, v);
                    const float* m = mnext + (size_t)b * 6144; norm_mod_row(v, gnext, m + 1024, m, lane); store_row_bf16(H + (size_t)row * DM, lane, v); }
            }
        }
        SEAM(pb + 7);
    }
#undef IN
#undef SEAM
}

extern "C" void kernel_launch(void* const* d_in, const int* in_sizes, int n_in, void* d_out, int out_size, void* d_ws, size_t ws_size, hipStream_t stream) {
    static int grid = 0;
    if (grid == 0) {
        if (n_in != 21 || ws_size < WS_END || out_size != T * DM) { fprintf(stderr, "kernel_launch: unexpected shapes (n_in %d, ws %zu, out %d)\n", n_in, ws_size, out_size); grid = -1; return; }
        int dev = 0, cus = 0;
        if (hipGetDevice(&dev) != hipSuccess || hipDeviceGetAttribute(&cus, hipDeviceAttributeMultiprocessorCount, dev) != hipSuccess) { grid = -1; return; }
        if (hipFuncSetAttribute((const void*)mk_fwd, hipFuncAttributeMaxDynamicSharedMemorySize, LDS_BYTES) != hipSuccess) { fprintf(stderr, "kernel_launch: hipFuncSetAttribute failed\n"); grid = -1; return; }
        int per_cu = 0;
        if (hipOccupancyMaxActiveBlocksPerMultiprocessor(&per_cu, (const void*)mk_fwd, NTHREADS, LDS_BYTES) != hipSuccess || per_cu < 1) { fprintf(stderr, "kernel_launch: occupancy query says %d\n", per_cu); }
        (void)hipGetLastError();
        grid = cus;
    }
    if (grid < 0) return;
    const float* lambda_ = (const float*)d_in[7]; const float* subln = (const float*)d_in[8]; const float* na_rpb = (const float*)d_in[9];
    const float* conv_dw = (const float*)d_in[10]; const float* conv_b = (const float*)d_in[11]; const float* conv_g = (const float*)d_in[12]; const float* conv_bn = (const float*)d_in[13];
    (void)lambda_;
    unsigned char* ws = (unsigned char*)d_ws;
    float* lamv = (float*)(ws + OFF_LAM); bf16_t* P = (bf16_t*)(ws + OFF_P); bf16_t* CC = (bf16_t*)(ws + OFF_C);
    (void)hipMemsetAsync(ws + OFF_CTL, 0, CTL_BYTES, stream);
    Args a{};
    for (int i = 0; i < 21; ++i) a.in[i] = (const float*)d_in[i];
    a.out = (float*)d_out; a.ws = ws;
    auto run = [&](int lo, int hi) { a.ph_lo = lo; a.ph_hi = hi; hipLaunchKernelGGL(mk_fwd, dim3(grid), dim3(NTHREADS), LDS_BYTES, stream, a); };
    run(0, NPH);
}
```

```cpp
#include <hip/hip_runtime.h>
#include <cstdio>
#include <cstdint>

constexpr int BATCH = 8, SEQ = 2048, DM = 1024, T = BATCH * SEQ, DEPTH = 2;
constexpr int P_IN = 2816, NE = 32, DE = 512, NSLOT = (T * 2 / 256 + NE) * 256;
constexpr float EPS = 1e-6f, LOG2E = 1.4426950408889634f;
constexpr size_t TENS = (size_t)BATCH * 4 * SEQ * 64;

constexpr size_t MiB = 1u << 20;
constexpr size_t OFF_CTL = 0, CTL_BYTES = 64 * 1024;
constexpr size_t OFF_MOD = 64 * 1024;
constexpr size_t OFF_ROT = 512 * 1024;
constexpr size_t OFF_LAM = 1280 * 1024;
constexpr size_t OFF_ROUTE = 1536 * 1024;
constexpr size_t OFF_W = 2 * MiB;
constexpr size_t OFF_PRAW = 18 * MiB;
constexpr size_t OFF_X1 = 210 * MiB, OFF_X2 = 274 * MiB, OFF_H = 338 * MiB, OFF_P = 370 * MiB, OFF_C = 450 * MiB, OFF_RT = 490 * MiB, OFF_ET = 492 * MiB, WS_END = 494 * MiB;
constexpr int CW_CNT = 4096;

typedef unsigned short bf16_t;
typedef float f32x4 __attribute__((ext_vector_type(4)));
typedef unsigned u32x4 __attribute__((ext_vector_type(4)));
typedef unsigned u32x2 __attribute__((ext_vector_type(2)));

__device__ __forceinline__ unsigned f2bf(float f) { unsigned u = __builtin_bit_cast(unsigned, f); return (u + 0x7fffu + ((u >> 16) & 1u)) >> 16; }
__device__ __forceinline__ unsigned pk2(float lo, float hi) { return f2bf(lo) | (f2bf(hi) << 16); }
__device__ __forceinline__ float bf2f(unsigned short h) { return __builtin_bit_cast(float, (unsigned)h << 16); }
__device__ __forceinline__ float bflo(unsigned w) { return __builtin_bit_cast(float, w << 16); }
__device__ __forceinline__ float bfhi(unsigned w) { return __builtin_bit_cast(float, w & 0xffff0000u); }
template <int CTRL, int RMASK> __device__ __forceinline__ float dpp_mov0(float v) {
    return __builtin_bit_cast(float, __builtin_amdgcn_update_dpp(0, __builtin_bit_cast(int, v), CTRL, RMASK, 0xf, false));
}
__device__ __forceinline__ float wave_sum(float v) {
    v += dpp_mov0<0xB1, 0xf>(v); v += dpp_mov0<0x4E, 0xf>(v); v += dpp_mov0<0x141, 0xf>(v); v += dpp_mov0<0x140, 0xf>(v);
    v += dpp_mov0<0x142, 0xa>(v); v += dpp_mov0<0x143, 0xc>(v);
    return __builtin_bit_cast(float, __builtin_amdgcn_readlane(__builtin_bit_cast(int, v), 63));
}
__device__ __forceinline__ float silu_f(float v) { return v / (1.f + __expf(-v)); }

__global__ void k_tables(float* rot, float* lamv, const float* diff_lambda) {
    const int pos = blockIdx.x, i = threadIdx.x;
    float* cos64 = rot; float* sin64 = rot + 2048 * 32; float* cos32 = rot + 2 * 2048 * 32; float* sin32 = cos32 + 2048 * 16;
    if (i < 32) { const double inv = pow(10000.0, -(double)i / 32.0), a = (double)pos * inv; cos64[pos * 32 + i] = (float)cos(a); sin64[pos * 32 + i] = (float)sin(a); }
    if (i < 16) { const double inv = pow(10000.0, -(double)i / 16.0), a = (double)pos * inv; cos32[pos * 16 + i] = (float)cos(a); sin32[pos * 16 + i] = (float)sin(a); }
    if (pos == 0 && i < DEPTH) {
        const float* lp = diff_lambda + i * 4 * 32; float s01 = 0.f, s23 = 0.f;
        for (int e = 0; e < 32; ++e) { s01 += lp[e] * lp[32 + e]; s23 += lp[64 + e] * lp[96 + e]; }
        const float lam_init = 0.8f - 0.6f * expf(-0.3f * (float)i);
        lamv[2 * i] = expf(s01) - expf(s23) + lam_init; lamv[2 * i + 1] = 1.f - lam_init;
    }
}
__global__ void k_adaln(const float* c, const float* w_ada, const float* b_ada, float* mod) {
    const int n = blockIdx.x * 256 + threadIdx.x, b = blockIdx.y, l = blockIdx.z;
    const float* w = w_ada + (size_t)l * DM * 6144 + n; const float* cb = c + b * DM;
    float acc = b_ada[l * 6144 + n];
    for (int d = 0; d < DM; ++d) acc += silu_f(cb[d]) * w[(size_t)d * 6144];
    mod[((size_t)l * BATCH + b) * 6144 + n] = acc;
}
__device__ __forceinline__ void load_row(const float* xr, int lane, f32x4 (&v)[4]) {
#pragma unroll
    for (int j = 0; j < 4; ++j) v[j] = *(const f32x4*)(xr + 256 * j + 4 * lane);
}
__device__ __forceinline__ void norm_mod_row(f32x4 (&v)[4], const float* g, const float* sc, const float* sh, int lane) {
    float s = 0.f;
#pragma unroll
    for (int j = 0; j < 4; ++j) s += (v[j].x * v[j].x + v[j].y * v[j].y) + (v[j].z * v[j].z + v[j].w * v[j].w);
    const float rstd = 1.0f / sqrtf(wave_sum(s) * (1.f / DM) + EPS);
#pragma unroll
    for (int j = 0; j < 4; ++j) {
        const f32x4 gg = *(const f32x4*)(g + 256 * j + 4 * lane);
        f32x4 y = v[j] * rstd * gg;
        if (sc) { const f32x4 a = *(const f32x4*)(sc + 256 * j + 4 * lane), b = *(const f32x4*)(sh + 256 * j + 4 * lane); y = y * (1.f + a) + b; }
        v[j] = y;
    }
}
__device__ __forceinline__ void store_row_bf16(bf16_t* o, int lane, const f32x4 (&v)[4]) {
#pragma unroll
    for (int j = 0; j < 4; ++j) { u32x2 w; w.x = pk2(v[j].x, v[j].y); w.y = pk2(v[j].z, v[j].w); *(u32x2*)(o + 256 * j + 4 * lane) = w; }
}
__device__ __forceinline__ void store_row_f32(float* o, int lane, const f32x4 (&v)[4]) {
#pragma unroll
    for (int j = 0; j < 4; ++j) *(f32x4*)(o + 256 * j + 4 * lane) = v[j];
}
__global__ __launch_bounds__(256) void k_norm(const float* x, const float* g, const float* modl, bf16_t* h) {
    const int lane = threadIdx.x & 63, row = blockIdx.x * 4 + (threadIdx.x >> 6), b = row / SEQ;
    f32x4 v[4]; load_row(x + (size_t)row * DM, lane, v);
    const float* m = modl + (size_t)b * 6144;
    norm_mod_row(v, g, m + 1024, m, lane);
    store_row_bf16(h + (size_t)row * DM, lane, v);
}

template <int NB, class BSel, class Epi>
__global__ __launch_bounds__(256) void k_gemm_naive(const bf16_t* A, long long K_, BSel bsel, Epi epi) {
    const int K = (int)K_;
    __shared__ float As[16][68];
    __shared__ float Bs[NB][16][64];
    const int tid = threadIdx.x, tx = tid & 15, ty = tid >> 4, rt = blockIdx.y, ct = blockIdx.x;
    const float* Bp[NB]; int ldb;
    if (!bsel(rt, Bp, ldb)) return;
    float acc[NB][4][4];
#pragma unroll
    for (int q = 0; q < NB; ++q)
#pragma unroll
        for (int i = 0; i < 4; ++i)
#pragma unroll
            for (int j = 0; j < 4; ++j) acc[q][i][j] = 0.f;
    const int ar = tid >> 2, ak = (tid & 3) * 4, bk = tid >> 4, bn = (tid & 15) * 4;
    for (int k0 = 0; k0 < K; k0 += 16) {
        const u32x2 aw = *(const u32x2*)(A + (size_t)(rt * 64 + ar) * K + k0 + ak);
        As[ak + 0][ar] = bflo(aw.x); As[ak + 1][ar] = bfhi(aw.x); As[ak + 2][ar] = bflo(aw.y); As[ak + 3][ar] = bfhi(aw.y);
#pragma unroll
        for (int q = 0; q < NB; ++q) *(f32x4*)&Bs[q][bk][bn] = *(const f32x4*)(Bp[q] + (size_t)(k0 + bk) * ldb + ct * 64 + bn);
        __syncthreads();
#pragma unroll
        for (int k = 0; k < 16; ++k) {
            const f32x4 a = *(const f32x4*)&As[k][ty * 4];
#pragma unroll
            for (int q = 0; q < NB; ++q) { const f32x4 b = *(const f32x4*)&Bs[q][k][tx * 4];
#pragma unroll
                for (int i = 0; i < 4; ++i)
#pragma unroll
                    for (int j = 0; j < 4; ++j) acc[q][i][j] += a[i] * b[j]; }
        }
        __syncthreads();
    }
#pragma unroll
    for (int i = 0; i < 4; ++i)
#pragma unroll
        for (int j = 0; j < 4; ++j) { float v[NB];
#pragma unroll
            for (int q = 0; q < NB; ++q) v[q] = acc[q][i][j];
            epi(rt * 64 + ty * 4 + i, ct * 64 + tx * 4 + j, v); }
}
struct BSelPlain { const float* B; int ldb; int pad; __device__ bool operator()(int, const float* (&Bp)[1], int& l) const { Bp[0] = B; l = ldb; return true; } };
struct EpiRaw { float* C; int ldc; int pad; __device__ void operator()(int r, int c, const float (&v)[1]) const { C[(size_t)r * ldc + c] = v[0]; } };
struct EpiResid { const float* xin; const float* modl; float* out; __device__ void operator()(int r, int c, const float (&v)[1]) const {
    const int b = r / SEQ; out[(size_t)r * DM + c] = xin[(size_t)r * DM + c] + modl[(size_t)b * 6144 + 2048 + c] * v[0]; } };
__device__ __forceinline__ int expert_of_row(const unsigned* cnt, int row, int& total) {
    int start = 0, e_found = -1;
    for (int e = 0; e < NE; ++e) { const int pad = ((int)cnt[e] + 255) / 256 * 256; if (row >= start && row < start + pad) e_found = e; start += pad; }
    total = start; return e_found;
}
struct BSelGU { const unsigned* cnt; const float* wg; const float* wu; __device__ bool operator()(int rt, const float* (&Bp)[2], int& l) const {
    int total; const int e = expert_of_row(cnt, rt * 64, total); if (e < 0) return false;
    Bp[0] = wg + (size_t)e * DM * DE; Bp[1] = wu + (size_t)e * DM * DE; l = DE; return true; } };
struct EpiGU { bf16_t* hdn; __device__ void operator()(int r, int c, const float (&v)[2]) const { hdn[(size_t)r * DE + c] = (bf16_t)f2bf(silu_f(v[0]) * v[1]); } };
struct BSelDN { const unsigned* cnt; const float* wd; __device__ bool operator()(int rt, const float* (&Bp)[1], int& l) const {
    int total; const int e = expert_of_row(cnt, rt * 64, total); if (e < 0) return false;
    Bp[0] = wd + (size_t)e * DE * DM; l = DM; return true; } };
struct EpiY { bf16_t* y; __device__ void operator()(int r, int c, const float (&v)[1]) const { y[(size_t)r * DM + c] = (bf16_t)f2bf(v[0]); } };

__global__ __launch_bounds__(256) void k_postproj(const float* raw, const float* rot, bf16_t* P) {
    const int t = blockIdx.x, pn = blockIdx.y, pc = threadIdx.x, b = t / SEQ, s = t % SEQ;
    const float* r = raw + (size_t)t * P_IN;
    const float* cos64 = rot; const float* sin64 = rot + 2048 * 32; const float* cos32 = rot + 2 * 2048 * 32; const float* sin32 = cos32 + 2048 * 16;
    const int h = pc >> 6, e = pc & 63;
    float val; int tens;
    if (pn == 0 || pn == 1) {
        const int cmap = e >> 5, p = e & 31, i = p >> 1, odd = p & 1, base = pn * 256 + h * 64 + cmap * 32;
        const float x1 = r[base + i], x2 = r[base + i + 16], cs = cos32[s * 16 + i], sn = sin32[s * 16 + i];
        val = odd ? (x2 * cs + x1 * sn) : (x1 * cs - x2 * sn);
        if (pn == 0) val *= 0.17677669529663687f * LOG2E;
        tens = pn;
    } else if (pn == 8 || pn == 9) {
        const int i = e >> 1, odd = e & 1, base = 2048 + (pn - 8) * 256 + h * 64;
        const float x1 = r[base + i], x2 = r[base + i + 32], cs = cos64[s * 32 + i], sn = sin64[s * 32 + i];
        val = odd ? (x2 * cs + x1 * sn) : (x1 * cs - x2 * sn);
        if (pn == 8) val *= 0.125f * LOG2E;
        tens = pn - 2;
    } else if (pn == 6 || pn == 7) {
        if (pn == 7) return;
        const float a = r[1536 + pc], g = r[1792 + pc];
        P[9 * TENS + (size_t)t * 256 + pc] = (bf16_t)f2bf(a / (1.f + __expf(-g)));
        return;
    } else {
        const int src = (pn <= 5) ? pn * 256 + pc : 2048 + 512 + pc;
        val = r[src];
        if (pn == 3) val *= 0.125f * LOG2E;
        tens = (pn <= 5) ? pn : 8;
    }
    P[(size_t)tens * TENS + (((size_t)b * 4 + h) * SEQ + s) * 64 + e] = (bf16_t)f2bf(val);
}

__device__ __forceinline__ void load64(const bf16_t* p, float (&q)[64]) {
#pragma unroll
    for (int i = 0; i < 8; ++i) { const u32x4 w = *(const u32x4*)(p + 8 * i);
        q[8 * i + 0] = bflo(w.x); q[8 * i + 1] = bfhi(w.x); q[8 * i + 2] = bflo(w.y); q[8 * i + 3] = bfhi(w.y);
        q[8 * i + 4] = bflo(w.z); q[8 * i + 5] = bfhi(w.z); q[8 * i + 6] = bflo(w.w); q[8 * i + 7] = bfhi(w.w); }
}
template <int OFF, int N8> __device__ __forceinline__ float dot_row(const bf16_t* kp, const float (&q)[64]) {
    float s = 0.f;
#pragma unroll
    for (int i = 0; i < N8; ++i) { const u32x4 w = *(const u32x4*)(kp + 8 * i);
        s += q[OFF + 8 * i + 0] * bflo(w.x) + q[OFF + 8 * i + 1] * bfhi(w.x) + q[OFF + 8 * i + 2] * bflo(w.y) + q[OFF + 8 * i + 3] * bfhi(w.y)
           + q[OFF + 8 * i + 4] * bflo(w.z) + q[OFF + 8 * i + 5] * bfhi(w.z) + q[OFF + 8 * i + 6] * bflo(w.w) + q[OFF + 8 * i + 7] * bfhi(w.w); }
    return s;
}
__device__ __forceinline__ void axpy_row(const bf16_t* vp, float a, float (&o)[64]) {
#pragma unroll
    for (int i = 0; i < 8; ++i) { const u32x4 w = *(const u32x4*)(vp + 8 * i);
        o[8 * i + 0] += a * bflo(w.x); o[8 * i + 1] += a * bfhi(w.x); o[8 * i + 2] += a * bflo(w.y); o[8 * i + 3] += a * bfhi(w.y);
        o[8 * i + 4] += a * bflo(w.z); o[8 * i + 5] += a * bfhi(w.z); o[8 * i + 6] += a * bflo(w.w); o[8 * i + 7] += a * bfhi(w.w); }
}
__device__ __forceinline__ void store64_bf16(bf16_t* p, const float (&o)[64]) {
#pragma unroll
    for (int i = 0; i < 8; ++i) { u32x4 w; w.x = pk2(o[8 * i], o[8 * i + 1]); w.y = pk2(o[8 * i + 2], o[8 * i + 3]); w.z = pk2(o[8 * i + 4], o[8 * i + 5]); w.w = pk2(o[8 * i + 6], o[8 * i + 7]); *(u32x4*)(p + 8 * i) = w; }
}
__global__ __launch_bounds__(64) void k_attnA_naive(const bf16_t* P, const float* lamv, const float* subln, bf16_t* concat) {
    const int gq = blockIdx.x * 64 + threadIdx.x, bh = gq >> 11, q = gq & 2047, b = bh >> 2, h = bh & 3;
    const bf16_t* Kb = P + 1 * TENS + (size_t)bh * SEQ * 64; const bf16_t* Vb = P + 2 * TENS + (size_t)bh * SEQ * 64;
    float qv[64]; load64(P + (size_t)gq * 64, qv);
    float m0 = -1e30f, l0 = 0.f, m1 = -1e30f, l1 = 0.f;
    for (int k = 0; k < SEQ; ++k) {
        const float s0 = dot_row<0, 4>(Kb + (size_t)k * 64, qv), s1 = dot_row<32, 4>(Kb + (size_t)k * 64 + 32, qv);
        if (s0 > m0) { l0 *= exp2f(m0 - s0); m0 = s0; } l0 += exp2f(s0 - m0);
        if (s1 > m1) { l1 *= exp2f(m1 - s1); m1 = s1; } l1 += exp2f(s1 - m1);
    }
    const float lam = lamv[0], r0 = 1.f / l0, r1 = lam / l1;
    float o[64];
#pragma unroll
    for (int e = 0; e < 64; ++e) o[e] = 0.f;
    for (int k = 0; k < SEQ; ++k) {
        const float s0 = dot_row<0, 4>(Kb + (size_t)k * 64, qv), s1 = dot_row<32, 4>(Kb + (size_t)k * 64 + 32, qv);
        const float a = exp2f(s0 - m0) * r0 - exp2f(s1 - m1) * r1;
        axpy_row(Vb + (size_t)k * 64, a, o);
    }
    float ss = 0.f;
#pragma unroll
    for (int e = 0; e < 64; ++e) ss += o[e] * o[e];
    const float rs = 1.0f / sqrtf(ss * (1.f / 64.f) + EPS) * lamv[1];
#pragma unroll
    for (int e = 0; e < 64; ++e) o[e] = o[e] * rs * subln[e];
    store64_bf16(concat + ((size_t)b * SEQ + q) * DM + h * 64, o);
}
__global__ __launch_bounds__(64) void k_attnB_naive(const bf16_t* P, const float* rpb, bf16_t* concat) {
    const int gq = blockIdx.x * 64 + threadIdx.x, bh = gq >> 11, s = gq & 2047, b = bh >> 2, h = bh & 3;
    const bf16_t* Kb = P + 4 * TENS + (size_t)bh * SEQ * 64; const bf16_t* Vb = P + 5 * TENS + (size_t)bh * SEQ * 64;
    float qv[64]; load64(P + 3 * TENS + (size_t)gq * 64, qv);
    const int i = s >> 6, j = s & 63, rs = min(max(i - 4, 0), 24), cs = min(max(j - 8, 0), 48);
    float m = -1e30f, l = 0.f, o[64];
#pragma unroll
    for (int e = 0; e < 64; ++e) o[e] = 0.f;
    for (int a = 0; a < 8; ++a) {
        const int row = rs + a, dr = row - i + 7;
        for (int cc = 0; cc < 16; ++cc) {
            const int c = cs + cc, key = row * 64 + c;
            const float sc = dot_row<0, 8>(Kb + (size_t)key * 64, qv) + rpb[(h * 15 + dr) * 31 + (c - j + 15)] * LOG2E;
            if (sc > m) { const float al = exp2f(m - sc); l *= al;
#pragma unroll
                for (int e = 0; e < 64; ++e) o[e] *= al;
                m = sc; }
            const float p = exp2f(sc - m); l += p; axpy_row(Vb + (size_t)key * 64, p, o);
        }
    }
    const float r = 1.f / l;
#pragma unroll
    for (int e = 0; e < 64; ++e) o[e] *= r;
    store64_bf16(concat + ((size_t)b * SEQ + s) * DM + 256 + h * 64, o);
}
__global__ __launch_bounds__(64) void k_attnD_naive(const bf16_t* P, bf16_t* concat) {
    const int gq = blockIdx.x * 64 + threadIdx.x, bh = gq >> 11, t = gq & 2047, b = bh >> 2, h = bh & 3;
    const bf16_t* Kb = P + 7 * TENS + (size_t)bh * SEQ * 64; const bf16_t* Vb = P + 8 * TENS + (size_t)bh * SEQ * 64;
    float qv[64]; load64(P + 6 * TENS + (size_t)gq * 64, qv);
    float m = -1e30f, l = 0.f, o[64];
#pragma unroll
    for (int e = 0; e < 64; ++e) o[e] = 0.f;
    for (int br = 0; br < 3; ++br) {
        const int dil = br == 0 ? 1 : (br == 1 ? 4 : 16);
        for (int mm = -64; mm <= 64; ++mm) {
            const int key = t + mm * dil;
            if (key < 0 || key >= SEQ) continue;
            const float sc = dot_row<0, 8>(Kb + (size_t)key * 64, qv);
            if (sc > m) { const float al = exp2f(m - sc); l *= al;
#pragma unroll
                for (int e = 0; e < 64; ++e) o[e] *= al;
                m = sc; }
            const float p = exp2f(sc - m); l += p; axpy_row(Vb + (size_t)key * 64, p, o);
        }
    }
    const float r = 1.f / l;
#pragma unroll
    for (int e = 0; e < 64; ++e) o[e] *= r;
    store64_bf16(concat + ((size_t)b * SEQ + t) * DM + 768 + h * 64, o);
}
__global__ __launch_bounds__(64) void k_conv_naive(const bf16_t* Z, const float* w_dw, const float* b_dw, const float* g_n, const float* b_n, bf16_t* concat) {
    const int id = blockIdx.x * 64 + threadIdx.x, t = id >> 2, g = id & 3, b = t / SEQ, s = t % SEQ;
    float v[64];
#pragma unroll
    for (int e = 0; e < 64; ++e) v[e] = b_dw[g * 64 + e];
    for (int k = 0; k < 31; ++k) {
        const int sp = s + k - 15; if (sp < 0 || sp >= SEQ) continue;
        const bf16_t* zr = Z + ((size_t)b * SEQ + sp) * 256 + g * 64; const float* wr = w_dw + k * 256 + g * 64;
#pragma unroll
        for (int e = 0; e < 64; ++e) v[e] += bf2f(zr[e]) * wr[e];
    }
    float mu = 0.f;
#pragma unroll
    for (int e = 0; e < 64; ++e) mu += v[e];
    mu *= (1.f / 64.f);
    float var = 0.f;
#pragma unroll
    for (int e = 0; e < 64; ++e) { const float d = v[e] - mu; var += d * d; }
    const float rstd = 1.0f / sqrtf(var * (1.f / 64.f) + EPS);
#pragma unroll
    for (int e = 0; e < 64; ++e) { const float zn = (v[e] - mu) * rstd * g_n[g * 64 + e] + b_n[g * 64 + e]; v[e] = silu_f(zn); }
    store64_bf16(concat + (size_t)t * DM + 512 + g * 64, v);
}

__global__ __launch_bounds__(512) void k_router(const float* x1, const float* g2, const float* modl, const float* w_rg, const float* w_re,
                                                bf16_t* h2, int* eid, float* gate, int* rank, unsigned* gcnt) {
    __shared__ int hist[NE]; __shared__ int basee[NE]; __shared__ int a_e[128]; __shared__ int a_lr[128];
    const int tid = threadIdx.x, lane = tid & 63, wid = tid >> 6;
    if (tid < NE) hist[tid] = 0;
    __syncthreads();
    for (int it = 0; it < 8; ++it) {
        const int lr = wid * 8 + it, row = blockIdx.x * 64 + lr, b = row / SEQ;
        f32x4 v[4]; load_row(x1 + (size_t)row * DM, lane, v);
        const float* m = modl + (size_t)b * 6144;
        norm_mod_row(v, g2, m + 4 * 1024, m + 3 * 1024, lane);
        store_row_bf16(h2 + (size_t)row * DM, lane, v);
        float lg[4] = {0.f, 0.f, 0.f, 0.f};
#pragma unroll
        for (int j = 0; j < 4; ++j)
#pragma unroll
            for (int k = 0; k < 4; ++k) { const f32x4 w = *(const f32x4*)(w_rg + (size_t)(256 * j + 4 * lane + k) * 4); const float xv = v[j][k];
                lg[0] += xv * w.x; lg[1] += xv * w.y; lg[2] += xv * w.z; lg[3] += xv * w.w; }
#pragma unroll
        for (int g = 0; g < 4; ++g) lg[g] = wave_sum(lg[g]);
        int grp = 0; float best = lg[0];
#pragma unroll
        for (int g = 1; g < 4; ++g) if (lg[g] > best) { best = lg[g]; grp = g; }
        float den = 0.f;
#pragma unroll
        for (int g = 0; g < 4; ++g) den += expf(lg[g] - best);
        const float p_grp = 1.f / den;
        float le[8];
#pragma unroll
        for (int e = 0; e < 8; ++e) le[e] = 0.f;
        const float* wre = w_re + (size_t)grp * DM * 8;
#pragma unroll
        for (int j = 0; j < 4; ++j)
#pragma unroll
            for (int k = 0; k < 4; ++k) { const float* wp = wre + (size_t)(256 * j + 4 * lane + k) * 8; const f32x4 w0 = *(const f32x4*)wp, w1 = *(const f32x4*)(wp + 4); const float xv = v[j][k];
                le[0] += xv * w0.x; le[1] += xv * w0.y; le[2] += xv * w0.z; le[3] += xv * w0.w; le[4] += xv * w1.x; le[5] += xv * w1.y; le[6] += xv * w1.z; le[7] += xv * w1.w; }
#pragma unroll
        for (int e = 0; e < 8; ++e) le[e] = wave_sum(le[e]);
        int i0 = 0; float v0 = le[0];
#pragma unroll
        for (int e = 1; e < 8; ++e) if (le[e] > v0) { v0 = le[e]; i0 = e; }
        int i1 = -1; float v1 = -3.0e38f;
#pragma unroll
        for (int e = 0; e < 8; ++e) if (e != i0 && le[e] > v1) { v1 = le[e]; i1 = e; }
        const float e1 = expf(v1 - v0), gt0 = p_grp / (1.f + e1), gt1 = p_grp * e1 / (1.f + e1);
        if (lane == 0) {
            const int ea = grp * 8 + i0, eb = grp * 8 + i1;
            eid[row * 2] = ea; eid[row * 2 + 1] = eb; gate[row * 2] = gt0; gate[row * 2 + 1] = gt1;
            a_e[lr * 2] = ea; a_e[lr * 2 + 1] = eb;
            a_lr[lr * 2] = atomicAdd(&hist[ea], 1); a_lr[lr * 2 + 1] = atomicAdd(&hist[eb], 1);
        }
    }
    __syncthreads();
    if (tid < NE) basee[tid] = (int)atomicAdd(&gcnt[tid], (unsigned)hist[tid]);
    __syncthreads();
    if (tid < 128) rank[blockIdx.x * 128 + tid] = basee[a_e[tid]] + a_lr[tid];
}
__global__ __launch_bounds__(256) void k_scatter(const bf16_t* h2, const int* eid, const int* rank, const unsigned* gcnt, bf16_t* xb, int* tokslot) {
    __shared__ int pstart[NE];
    if (threadIdx.x == 0) { int s = 0; for (int e = 0; e < NE; ++e) { pstart[e] = s; s += ((int)gcnt[e] + 255) / 256 * 256; } }
    __syncthreads();
    const int lane = threadIdx.x & 63, row = blockIdx.x * 4 + (threadIdx.x >> 6);
    const u32x4* src = (const u32x4*)(h2 + (size_t)row * DM);
    const u32x4 a = src[lane], b = src[64 + lane];
#pragma unroll
    for (int k = 0; k < 2; ++k) {
        const int slot = pstart[eid[row * 2 + k]] + rank[row * 2 + k];
        u32x4* dst = (u32x4*)(xb + (size_t)slot * DM); dst[lane] = a; dst[64 + lane] = b;
        if (lane == 0) tokslot[row * 2 + k] = slot;
    }
}
__device__ __forceinline__ void load_row_bf16(const bf16_t* p, int lane, f32x4 (&v)[4]) {
#pragma unroll
    for (int j = 0; j < 4; ++j) { const u32x2 w = *(const u32x2*)(p + 256 * j + 4 * lane); v[j] = (f32x4){bflo(w.x), bfhi(w.x), bflo(w.y), bfhi(w.y)}; }
}
__global__ __launch_bounds__(256) void k_combine(const float* x1, const bf16_t* y, const int* tokslot, const float* gate, const float* modl,
                                                 float* x2, const float* g_next, const float* mod_next, bf16_t* h_next, const float* g_final, float* out) {
    const int lane = threadIdx.x & 63, row = blockIdx.x * 4 + (threadIdx.x >> 6), b = row / SEQ;
    f32x4 v[4], y0[4], y1[4]; load_row(x1 + (size_t)row * DM, lane, v);
    load_row_bf16(y + (size_t)tokslot[row * 2] * DM, lane, y0); load_row_bf16(y + (size_t)tokslot[row * 2 + 1] * DM, lane, y1);
    const float g0 = gate[row * 2], g1 = gate[row * 2 + 1];
    const float* gt2 = modl + (size_t)b * 6144 + 5 * 1024;
#pragma unroll
    for (int j = 0; j < 4; ++j) { const f32x4 gg = *(const f32x4*)(gt2 + 256 * j + 4 * lane); v[j] = v[j] + gg * (y0[j] * g0 + y1[j] * g1); }
    if (out) { norm_mod_row(v, g_final, nullptr, nullptr, lane); store_row_f32(out + (size_t)row * DM, lane, v); }
    else { store_row_f32(x2 + (size_t)row * DM, lane, v);
        const float* m = mod_next + (size_t)b * 6144; norm_mod_row(v, g_next, m + 1024, m, lane); store_row_bf16(h_next + (size_t)row * DM, lane, v); }
}

namespace pg8 {
#define PG8_LAS __attribute__((address_space(3)))
typedef unsigned short bf16_t;
typedef short bf16x8 __attribute__((ext_vector_type(8)));
typedef float f32x4 __attribute__((ext_vector_type(4)));
typedef unsigned u32x4 __attribute__((ext_vector_type(4)));
constexpr int BM = 256, BK = 64, HALF = 128, HTB = HALF * BK * 2  , STAGE_BYTES = 8 * HTB, NXCD = 8, WGM = 8;

__host__ __device__ __forceinline__ int lds_byte(int r, int c) { const int st = (r >> 4) * 2 + (c >> 5), rr = r & 15, cc = c & 31, ob = rr * 64 + cc * 2; return st * 1024 + (ob ^ (((ob >> 9) & 1) << 5)); }
__host__ __device__ __forceinline__ void stage_rc(int b, int& R, int& C) { const int st = b / 1024, sb = b % 1024, swz = sb ^ (((sb >> 9) & 1) << 5); R = (st >> 1) * 16 + swz / 64; C = (st & 1) * 32 + (swz % 64) / 2; }
__host__ __device__ __forceinline__ int perm32(int rho) { const int n = rho >> 4, i = rho & 15; return 8 * (i >> 2) + 4 * n + (i & 3); }

struct Unit { int pm, pn; };
struct Gemm { const bf16_t* A; const bf16_t* Bt; int M, N, K; };

struct StaticOrder {
    int nM, nN, nwg, G, c;
    __host__ __device__ void init(int M, int N, int G_, int c_) { nM = M / BM; nN = N / BM; nwg = nM * nN; G = G_; c = c_; }
    __host__ __device__ bool next(int i, Unit& u) const {
        const long L = (long)i * G + c; if (L >= nwg) return false;
        int wgid = (int)L; { const int q = nwg / NXCD, r = nwg % NXCD, xcd = wgid % NXCD, off = wgid / NXCD; wgid = (xcd < r ? xcd * (q + 1) : r * (q + 1) + (xcd - r) * q) + off; }
        const int nig = WGM * nN, gid = wgid / nig, fm = gid * WGM, gsz = (nM - fm) < WGM ? (nM - fm) : WGM;
        u.pm = fm + ((wgid % nig) % gsz); u.pn = (wgid % nig) / gsz; return true;
    }
    __device__ __forceinline__ void a_ready(const Unit&) const {}
    __device__ __forceinline__ void done(const Unit&) const {}
};

__device__ __forceinline__ unsigned cvt_pk_bf16(float lo, float hi) { unsigned r; asm volatile("v_cvt_pk_bf16_f32 %0, %1, %2" : "=v"(r) : "v"(lo), "v"(hi)); return r; }
typedef float f32x2 __attribute__((ext_vector_type(2)));
template <class Epi, class Sched, bool ALIGN_EPI = false, bool SP2 = false>
__device__ __forceinline__ void gemm_phase(PG8_LAS unsigned char* lds, const Gemm g, const Sched& S, const Epi& E) {
    int tid_ = threadIdx.x; asm volatile("" : "+v"(tid_)); const int tid = tid_, wid = __builtin_amdgcn_readfirstlane(tid >> 6), lane = tid & 63, wr = wid >> 2, wc = wid & 3, fr = lane & 15, fq = lane >> 4;
    const int K = g.K, nt = K / BK;
    unsigned voffA[2], voffB[2];
#pragma unroll
    for (int i = 0; i < 2; ++i) { int R, C; stage_rc(tid * 16 + i * 8192, R, C); const int Rb = Epi::PERM ? ((R & ~31) + perm32(R & 31)) : R;
        voffA[i] = (unsigned)(R * K + C) * 2u; voffB[i] = (unsigned)(Rb * K + C) * 2u; }
    const size_t kstep = (size_t)(BK * 2);
    const size_t hstep = (size_t)HALF * K * 2;
    const size_t tstep = 2 * hstep;
    const unsigned ldsw = (unsigned)wid * 1024u;
    const int aoff = lds_byte(wr * 64 + fr, fq * 8), boff = lds_byte(wc * 32 + fr, fq * 8);
#define PG8_SA(b, h) (((b) * 2 + (h)) * HTB)
#define PG8_SB(b, h) ((4 + (b) * 2 + (h)) * HTB)
#define PG8_STAGE(bufoff, gbase, voff) do { _Pragma("unroll") for (int _i = 0; _i < 2; ++_i) \
        __builtin_amdgcn_global_load_lds((const unsigned*)((const char*)(gbase) + (voff)[_i]), (PG8_LAS unsigned*)(lds + (bufoff) + ldsw + _i * 8192), 16, 0, 0); } while (0)
#define PG8_LDA(dst, b, h) do { _Pragma("unroll") for (int m = 0; m < 4; ++m) _Pragma("unroll") for (int k = 0; k < 2; ++k) dst[m][k] = *(const PG8_LAS bf16x8*)(lds + PG8_SA(b, h) + aoff + m * 2048 + k * 1024); } while (0)
#define PG8_LDB(dst, b, h) do { _Pragma("unroll") for (int n = 0; n < 2; ++n) _Pragma("unroll") for (int k = 0; k < 2; ++k) dst[n][k] = *(const PG8_LAS bf16x8*)(lds + PG8_SB(b, h) + boff + n * 2048 + k * 1024); } while (0)
#define PG8_MMA(ai, bj, At, Bt) do { __builtin_amdgcn_s_setprio(1); _Pragma("unroll") for (int m = 0; m < 4; ++m) _Pragma("unroll") for (int n = 0; n < 2; ++n) _Pragma("unroll") for (int k = 0; k < 2; ++k) \
        acc[ai][bj][m][n] = __builtin_amdgcn_mfma_f32_16x16x32_bf16(Bt[n][k], At[m][k], acc[ai][bj][m][n], 0, 0, 0); __builtin_amdgcn_s_setprio(0); } while (0)
#define PG8_WAIT_V(n) asm volatile("s_waitcnt vmcnt(" #n ")" ::: "memory")
#define PG8_WAIT_L(n) asm volatile("s_waitcnt lgkmcnt(" #n ")" ::: "memory")
#define PG8_BAR __builtin_amdgcn_s_barrier()
#define PG8_SCHED __builtin_amdgcn_sched_barrier(0)
    Unit cur, nxt; int ui = 0;
    if (!S.next(0, cur)) return;
    f32x4 acc[2][2][4][2];
#pragma unroll
    for (int a = 0; a < 2; ++a)
#pragma unroll
        for (int b = 0; b < 2; ++b)
#pragma unroll
            for (int m = 0; m < 4; ++m)
#pragma unroll
                for (int n = 0; n < 2; ++n) acc[a][b][m][n] = (f32x4){0.f, 0.f, 0.f, 0.f};
    bf16x8 At[4][2], B0[2][2], B1[2][2];
    const char* cA = (const char*)g.A + (size_t)cur.pm * tstep; const char* cB = (const char*)g.Bt + (size_t)cur.pn * tstep;
    S.a_ready(cur);
    if constexpr (SP2) {
        PG8_STAGE(PG8_SB(0, 0), cB, voffB); PG8_STAGE(PG8_SB(0, 1), cB + hstep, voffB); PG8_STAGE(PG8_SA(0, 0), cA, voffA); PG8_STAGE(PG8_SA(0, 1), cA + hstep, voffA);
        if (wr == 1) PG8_BAR;
        PG8_WAIT_V(2); PG8_BAR;
        PG8_STAGE(PG8_SB(1, 0), cB + kstep, voffB); PG8_STAGE(PG8_SA(1, 0), cA + kstep, voffA); PG8_STAGE(PG8_SB(1, 1), cB + hstep + kstep, voffB);
        PG8_WAIT_V(6); PG8_BAR;
    } else {
        PG8_STAGE(PG8_SB(0, 0), cB, voffB); PG8_STAGE(PG8_SA(0, 0), cA, voffA); PG8_STAGE(PG8_SB(0, 1), cB + hstep, voffB); PG8_STAGE(PG8_SA(0, 1), cA + hstep, voffA);
        if (wr == 1) PG8_BAR;
        PG8_WAIT_V(4); PG8_BAR;
        PG8_STAGE(PG8_SB(1, 0), cB + kstep, voffB); PG8_STAGE(PG8_SA(1, 0), cA + kstep, voffA); PG8_STAGE(PG8_SB(1, 1), cB + hstep + kstep, voffB);
        PG8_WAIT_V(6); PG8_BAR;
    }
    for (;;) {
        const bool has_next = S.next(ui + 1, nxt);
        const char* nA = has_next ? (const char*)g.A + (size_t)nxt.pm * tstep : cA; const char* nB = has_next ? (const char*)g.Bt + (size_t)nxt.pn * tstep : cB;
        for (int t = 0; t < nt; t += 2) {
            const bool last = (t == nt - 2);
            const char* a1 = cA + (size_t)(t + 1) * kstep;
            const char* a2 = last ? nA : cA + (size_t)(t + 2) * kstep; const char* b2 = last ? nB : cB + (size_t)(t + 2) * kstep;
            const char* a3 = a2 + kstep; const char* b3 = b2 + kstep;
            if (last && has_next) S.a_ready(nxt);
            if constexpr (SP2) {
            PG8_LDB(B0, 0, 0); PG8_LDB(B1, 0, 1); PG8_SCHED; PG8_LDA(At, 0, 0); PG8_STAGE(PG8_SA(1, 1), a1 + hstep, voffA);
            PG8_WAIT_V(8); PG8_WAIT_L(0); PG8_BAR; PG8_MMA(0, 0, At, B0); PG8_MMA(0, 1, At, B1); PG8_BAR; PG8_SCHED;
            PG8_LDA(At, 0, 1); PG8_STAGE(PG8_SB(0, 0), b2, voffB); PG8_STAGE(PG8_SB(0, 1), b2 + hstep, voffB); PG8_STAGE(PG8_SA(0, 0), a2, voffA);
            PG8_WAIT_V(8); PG8_WAIT_L(0); PG8_BAR; PG8_MMA(1, 0, At, B0); PG8_MMA(1, 1, At, B1); PG8_BAR; PG8_SCHED;
            PG8_LDB(B0, 1, 0); PG8_LDB(B1, 1, 1); PG8_SCHED; PG8_LDA(At, 1, 0); PG8_STAGE(PG8_SA(0, 1), a2 + hstep, voffA);
            PG8_WAIT_V(8); PG8_WAIT_L(0); PG8_BAR; PG8_MMA(0, 0, At, B0); PG8_MMA(0, 1, At, B1); PG8_BAR; PG8_SCHED;
            PG8_LDA(At, 1, 1); PG8_STAGE(PG8_SB(1, 0), b3, voffB); PG8_STAGE(PG8_SB(1, 1), b3 + hstep, voffB); PG8_STAGE(PG8_SA(1, 0), a3, voffA);
            PG8_WAIT_V(8); PG8_WAIT_L(0); PG8_BAR; PG8_MMA(1, 0, At, B0); PG8_MMA(1, 1, At, B1); PG8_BAR; PG8_SCHED;
            } else {
            PG8_LDB(B0, 0, 0); PG8_SCHED; PG8_LDA(At, 0, 0); PG8_STAGE(PG8_SA(1, 1), a1 + hstep, voffA);
            PG8_WAIT_L(8); PG8_BAR; PG8_WAIT_L(0); PG8_MMA(0, 0, At, B0); PG8_BAR; PG8_SCHED;
            PG8_LDB(B1, 0, 1); PG8_STAGE(PG8_SB(0, 0), b2, voffB);
            PG8_BAR; PG8_WAIT_L(0); PG8_MMA(0, 1, At, B1); PG8_BAR;
            PG8_LDA(At, 0, 1); PG8_STAGE(PG8_SA(0, 0), a2, voffA);
            PG8_BAR; PG8_WAIT_L(0); PG8_MMA(1, 0, At, B0); PG8_BAR; PG8_SCHED;
            PG8_STAGE(PG8_SB(0, 1), b2 + hstep, voffB);
            PG8_WAIT_V(6); PG8_BAR; PG8_MMA(1, 1, At, B1); PG8_BAR;
            PG8_LDB(B0, 1, 0); PG8_SCHED; PG8_LDA(At, 1, 0); PG8_STAGE(PG8_SA(0, 1), a2 + hstep, voffA);
            PG8_WAIT_L(8); PG8_BAR; PG8_WAIT_L(0); PG8_MMA(0, 0, At, B0); PG8_BAR; PG8_SCHED;
            PG8_LDB(B1, 1, 1); PG8_STAGE(PG8_SB(1, 0), b3, voffB);
            PG8_BAR; PG8_WAIT_L(0); PG8_MMA(0, 1, At, B1); PG8_BAR;
            PG8_LDA(At, 1, 1); PG8_STAGE(PG8_SA(1, 0), a3, voffA);
            PG8_BAR; PG8_WAIT_L(0); PG8_MMA(1, 0, At, B0); PG8_BAR; PG8_SCHED;
            PG8_STAGE(PG8_SB(1, 1), b3 + hstep, voffB);
            PG8_WAIT_V(6); PG8_BAR; PG8_MMA(1, 1, At, B1); PG8_BAR;
            }
        }
        if constexpr (ALIGN_EPI) { if (wr == 0) PG8_BAR; }
        if constexpr (!Epi::AFTER_DRAIN) { E(acc, cur, wr, wc, fr, fq); S.done(cur); }
        if (!has_next) break;
#pragma unroll
        for (int a = 0; a < 2; ++a)
#pragma unroll
            for (int b = 0; b < 2; ++b)
#pragma unroll
                for (int m = 0; m < 4; ++m)
#pragma unroll
                    for (int n = 0; n < 2; ++n) acc[a][b][m][n] = (f32x4){0.f, 0.f, 0.f, 0.f};
        cur = nxt; cA = nA; cB = nB; ++ui;
        if constexpr (ALIGN_EPI) { if (wr == 1) PG8_BAR; }
    }
    PG8_WAIT_V(0);
    if constexpr (!ALIGN_EPI) { if (wr == 0) PG8_BAR; }
    PG8_BAR;
    if constexpr (Epi::AFTER_DRAIN) { E.fused(acc, cur, wr, wc, fr, fq, lds, wid, lane); S.done(cur); }
#undef PG8_SA
#undef PG8_SB
#undef PG8_STAGE
#undef PG8_LDA
#undef PG8_LDB
#undef PG8_MMA
#undef PG8_WAIT_V
#undef PG8_WAIT_L
#undef PG8_BAR
#undef PG8_SCHED
}
template <class Epi, class Sched, bool ALIGN_EPI = false, bool SP2 = false>
__device__ __forceinline__ void gemm_phase_g(PG8_LAS unsigned char* lds, const Gemm g, const Sched& S, const Epi& E) {
    int tid_ = threadIdx.x; asm volatile("" : "+v"(tid_)); const int tid = tid_, wid = __builtin_amdgcn_readfirstlane(tid >> 6), lane = tid & 63, wr = wid >> 2, wc = wid & 3, fr = lane & 15, fq = lane >> 4;
    const int K = g.K, nt = K / BK;
    unsigned colA[2], voffB[2]; int RA[2];
#pragma unroll
    for (int i = 0; i < 2; ++i) { int R, C; stage_rc(tid * 16 + i * 8192, R, C); const int Rb = Epi::PERM ? ((R & ~31) + perm32(R & 31)) : R;
        RA[i] = R; colA[i] = (unsigned)C * 2u; voffB[i] = (unsigned)(Rb * K + C) * 2u; }
    const size_t kstep = (size_t)(BK * 2);
    const size_t hstep = (size_t)HALF * K * 2;
    const size_t tstep = 2 * hstep;
    const unsigned ldsw = (unsigned)wid * 1024u;
    const int aoff = lds_byte(wr * 64 + fr, fq * 8), boff = lds_byte(wc * 32 + fr, fq * 8);
#define PG8_SA(b, h) (((b) * 2 + (h)) * HTB)
#define PG8_SB(b, h) ((4 + (b) * 2 + (h)) * HTB)
#define PG8_STAGE(bufoff, gbase, voff) do { _Pragma("unroll") for (int _i = 0; _i < 2; ++_i) \
        __builtin_amdgcn_global_load_lds((const unsigned*)((const char*)(gbase) + (voff)[_i]), (PG8_LAS unsigned*)(lds + (bufoff) + ldsw + _i * 8192), 16, 0, 0); } while (0)
#define PG8_LDA(dst, b, h) do { _Pragma("unroll") for (int m = 0; m < 4; ++m) _Pragma("unroll") for (int k = 0; k < 2; ++k) dst[m][k] = *(const PG8_LAS bf16x8*)(lds + PG8_SA(b, h) + aoff + m * 2048 + k * 1024); } while (0)
#define PG8_LDB(dst, b, h) do { _Pragma("unroll") for (int n = 0; n < 2; ++n) _Pragma("unroll") for (int k = 0; k < 2; ++k) dst[n][k] = *(const PG8_LAS bf16x8*)(lds + PG8_SB(b, h) + boff + n * 2048 + k * 1024); } while (0)
#define PG8_MMA(ai, bj, At, Bt) do { __builtin_amdgcn_s_setprio(1); _Pragma("unroll") for (int m = 0; m < 4; ++m) _Pragma("unroll") for (int n = 0; n < 2; ++n) _Pragma("unroll") for (int k = 0; k < 2; ++k) \
        acc[ai][bj][m][n] = __builtin_amdgcn_mfma_f32_16x16x32_bf16(Bt[n][k], At[m][k], acc[ai][bj][m][n], 0, 0, 0); __builtin_amdgcn_s_setprio(0); } while (0)
#define PG8_WAIT_V(n) asm volatile("s_waitcnt vmcnt(" #n ")" ::: "memory")
#define PG8_WAIT_L(n) asm volatile("s_waitcnt lgkmcnt(" #n ")" ::: "memory")
#define PG8_BAR __builtin_amdgcn_s_barrier()
#define PG8_SCHED __builtin_amdgcn_sched_barrier(0)
    Unit cur, nxt; int ui = 0;
    if (!S.next(0, cur)) return;
    f32x4 acc[2][2][4][2];
#pragma unroll
    for (int a = 0; a < 2; ++a)
#pragma unroll
        for (int b = 0; b < 2; ++b)
#pragma unroll
            for (int m = 0; m < 4; ++m)
#pragma unroll
                for (int n = 0; n < 2; ++n) acc[a][b][m][n] = (f32x4){0.f, 0.f, 0.f, 0.f};
    bf16x8 At[4][2], B0[2][2], B1[2][2];
    unsigned vA[2][2], vAn[2][2];
    _Pragma("unroll") for (int h_ = 0; h_ < 2; ++h_) _Pragma("unroll") for (int i_ = 0; i_ < 2; ++i_) vA[h_][i_] = S.row_off(cur, h_ * HALF + RA[i_]) + colA[i_];
    const char* cA = (const char*)g.A; const char* cB = (const char*)g.Bt + (size_t)cur.pn * tstep;
    S.a_ready(cur);
    if constexpr (SP2) {
        PG8_STAGE(PG8_SB(0, 0), cB, voffB); PG8_STAGE(PG8_SB(0, 1), cB + hstep, voffB); PG8_STAGE(PG8_SA(0, 0), cA, vA[0]); PG8_STAGE(PG8_SA(0, 1), cA, vA[1]);
        if (wr == 1) PG8_BAR;
        PG8_WAIT_V(2); PG8_BAR;
        PG8_STAGE(PG8_SB(1, 0), cB + kstep, voffB); PG8_STAGE(PG8_SA(1, 0), cA + kstep, vA[0]); PG8_STAGE(PG8_SB(1, 1), cB + hstep + kstep, voffB);
        PG8_WAIT_V(6); PG8_BAR;
    } else {
        PG8_STAGE(PG8_SB(0, 0), cB, voffB); PG8_STAGE(PG8_SA(0, 0), cA, vA[0]); PG8_STAGE(PG8_SB(0, 1), cB + hstep, voffB); PG8_STAGE(PG8_SA(0, 1), cA, vA[1]);
        if (wr == 1) PG8_BAR;
        PG8_WAIT_V(4); PG8_BAR;
        PG8_STAGE(PG8_SB(1, 0), cB + kstep, voffB); PG8_STAGE(PG8_SA(1, 0), cA + kstep, vA[0]); PG8_STAGE(PG8_SB(1, 1), cB + hstep + kstep, voffB);
        PG8_WAIT_V(6); PG8_BAR;
    }
    for (;;) {
        const bool has_next = S.next(ui + 1, nxt);
        _Pragma("unroll") for (int h_ = 0; h_ < 2; ++h_) _Pragma("unroll") for (int i_ = 0; i_ < 2; ++i_) vAn[h_][i_] = has_next ? S.row_off(nxt, h_ * HALF + RA[i_]) + colA[i_] : vA[h_][i_];
        const char* nA = cA; const char* nB = has_next ? (const char*)g.Bt + (size_t)nxt.pn * tstep : cB;
        for (int t = 0; t < nt; t += 2) {
            const bool last = (t == nt - 2);
            const char* a1 = cA + (size_t)(t + 1) * kstep;
            const char* a2 = last ? nA : cA + (size_t)(t + 2) * kstep; const char* b2 = last ? nB : cB + (size_t)(t + 2) * kstep;
            const char* a3 = a2 + kstep; const char* b3 = b2 + kstep;
            unsigned vS[2][2];
            _Pragma("unroll") for (int h_ = 0; h_ < 2; ++h_) _Pragma("unroll") for (int i_ = 0; i_ < 2; ++i_) vS[h_][i_] = last ? vAn[h_][i_] : vA[h_][i_];
            if (last && has_next) S.a_ready(nxt);
            if constexpr (SP2) {
            PG8_LDB(B0, 0, 0); PG8_LDB(B1, 0, 1); PG8_SCHED; PG8_LDA(At, 0, 0); PG8_STAGE(PG8_SA(1, 1), a1, vA[1]);
            PG8_WAIT_V(8); PG8_WAIT_L(0); PG8_BAR; PG8_MMA(0, 0, At, B0); PG8_MMA(0, 1, At, B1); PG8_BAR; PG8_SCHED;
            PG8_LDA(At, 0, 1); PG8_STAGE(PG8_SB(0, 0), b2, voffB); PG8_STAGE(PG8_SB(0, 1), b2 + hstep, voffB); PG8_STAGE(PG8_SA(0, 0), a2, vS[0]);
            PG8_WAIT_V(8); PG8_WAIT_L(0); PG8_BAR; PG8_MMA(1, 0, At, B0); PG8_MMA(1, 1, At, B1); PG8_BAR; PG8_SCHED;
            PG8_LDB(B0, 1, 0); PG8_LDB(B1, 1, 1); PG8_SCHED; PG8_LDA(At, 1, 0); PG8_STAGE(PG8_SA(0, 1), a2, vS[1]);
            PG8_WAIT_V(8); PG8_WAIT_L(0); PG8_BAR; PG8_MMA(0, 0, At, B0); PG8_MMA(0, 1, At, B1); PG8_BAR; PG8_SCHED;
            PG8_LDA(At, 1, 1); PG8_STAGE(PG8_SB(1, 0), b3, voffB); PG8_STAGE(PG8_SB(1, 1), b3 + hstep, voffB); PG8_STAGE(PG8_SA(1, 0), a3, vS[0]);
            PG8_WAIT_V(8); PG8_WAIT_L(0); PG8_BAR; PG8_MMA(1, 0, At, B0); PG8_MMA(1, 1, At, B1); PG8_BAR; PG8_SCHED;
            } else {
            PG8_LDB(B0, 0, 0); PG8_SCHED; PG8_LDA(At, 0, 0); PG8_STAGE(PG8_SA(1, 1), a1, vA[1]);
            PG8_WAIT_L(8); PG8_BAR; PG8_WAIT_L(0); PG8_MMA(0, 0, At, B0); PG8_BAR; PG8_SCHED;
            PG8_LDB(B1, 0, 1); PG8_STAGE(PG8_SB(0, 0), b2, voffB);
            PG8_BAR; PG8_WAIT_L(0); PG8_MMA(0, 1, At, B1); PG8_BAR;
            PG8_LDA(At, 0, 1); PG8_STAGE(PG8_SA(0, 0), a2, vS[0]);
            PG8_BAR; PG8_WAIT_L(0); PG8_MMA(1, 0, At, B0); PG8_BAR; PG8_SCHED;
            PG8_STAGE(PG8_SB(0, 1), b2 + hstep, voffB);
            PG8_WAIT_V(6); PG8_BAR; PG8_MMA(1, 1, At, B1); PG8_BAR;
            PG8_LDB(B0, 1, 0); PG8_SCHED; PG8_LDA(At, 1, 0); PG8_STAGE(PG8_SA(0, 1), a2, vS[1]);
            PG8_WAIT_L(8); PG8_BAR; PG8_WAIT_L(0); PG8_MMA(0, 0, At, B0); PG8_BAR; PG8_SCHED;
            PG8_LDB(B1, 1, 1); PG8_STAGE(PG8_SB(1, 0), b3, voffB);
            PG8_BAR; PG8_WAIT_L(0); PG8_MMA(0, 1, At, B1); PG8_BAR;
            PG8_LDA(At, 1, 1); PG8_STAGE(PG8_SA(1, 0), a3, vS[0]);
            PG8_BAR; PG8_WAIT_L(0); PG8_MMA(1, 0, At, B0); PG8_BAR; PG8_SCHED;
            PG8_STAGE(PG8_SB(1, 1), b3 + hstep, voffB);
            PG8_WAIT_V(6); PG8_BAR; PG8_MMA(1, 1, At, B1); PG8_BAR;
            }
        }
        if constexpr (ALIGN_EPI) { if (wr == 0) PG8_BAR; }
        if constexpr (!Epi::AFTER_DRAIN) { E(acc, cur, wr, wc, fr, fq); S.done(cur); }
        if (!has_next) break;
#pragma unroll
        for (int a = 0; a < 2; ++a)
#pragma unroll
            for (int b = 0; b < 2; ++b)
#pragma unroll
                for (int m = 0; m < 4; ++m)
#pragma unroll
                    for (int n = 0; n < 2; ++n) acc[a][b][m][n] = (f32x4){0.f, 0.f, 0.f, 0.f};
        cur = nxt; cA = nA; cB = nB; ++ui;
        _Pragma("unroll") for (int h_ = 0; h_ < 2; ++h_) _Pragma("unroll") for (int i_ = 0; i_ < 2; ++i_) vA[h_][i_] = vAn[h_][i_];
        if constexpr (ALIGN_EPI) { if (wr == 1) PG8_BAR; }
    }
    PG8_WAIT_V(0);
    if constexpr (!ALIGN_EPI) { if (wr == 0) PG8_BAR; }
    PG8_BAR;
    if constexpr (Epi::AFTER_DRAIN) { E.fused(acc, cur, wr, wc, fr, fq, lds, wid, lane); S.done(cur); }
#undef PG8_SA
#undef PG8_SB
#undef PG8_STAGE
#undef PG8_LDA
#undef PG8_LDB
#undef PG8_MMA
#undef PG8_WAIT_V
#undef PG8_WAIT_L
#undef PG8_BAR
#undef PG8_SCHED
}
}

typedef short bf16x8 __attribute__((ext_vector_type(8)));
typedef short s16x4 __attribute__((ext_vector_type(4)));
typedef float f32x16 __attribute__((ext_vector_type(16)));
#define MLAS __attribute__((address_space(3)))
constexpr int AK_STRIDE = 144, AV_STRIDE = 192, AK_BYTES = 32 * AK_STRIDE, AV_BYTES = 32 * AV_STRIDE, AW_BYTES = AK_BYTES + AV_BYTES;
constexpr int AB_OFF = 8 * AW_BYTES, AB_BYTES = 2048;
static_assert(AB_OFF + 8 * AB_BYTES <= 131072, "mixer LDS");
__device__ __forceinline__ int crow(int r, int hh) { return (r & 3) + 8 * (r >> 2) + 4 * hh; }
__device__ __forceinline__ unsigned cvtpk(float lo, float hi) { unsigned r; asm volatile("v_cvt_pk_bf16_f32 %0, %1, %2" : "=v"(r) : "v"(lo), "v"(hi)); return r; }
template <int OFF> __device__ __forceinline__ s16x4 tr_read(unsigned a) { s16x4 r; asm volatile("ds_read_b64_tr_b16 %0, %1 offset:%2" : "=&v"(r) : "v"(a), "i"(OFF) : "memory"); return r; }
__device__ __forceinline__ float xhalf_max(float v) { auto rr = __builtin_amdgcn_permlane32_swap(__float_as_uint(v), __float_as_uint(v), false, false); return fmaxf(__uint_as_float(rr[0]), __uint_as_float(rr[1])); }
__device__ __forceinline__ float xhalf_sum(float v) { auto rr = __builtin_amdgcn_permlane32_swap(__float_as_uint(v), __float_as_uint(v), false, false); return __uint_as_float(rr[0]) + __uint_as_float(rr[1]); }

struct TileRegs { u32x4 k[4], v[4]; };
__device__ __forceinline__ void tile_load(TileRegs& t, const bf16_t* Kb, const bf16_t* Vb, int tok0, int tstride, int lane) {
#pragma unroll
    for (int i = 0; i < 4; ++i) { const int id = lane + 64 * i, kk = id >> 3, ch = id & 7; const size_t off = (size_t)(tok0 + kk * tstride) * 64 + ch * 8;
        t.k[i] = *(const u32x4*)(Kb + off); t.v[i] = *(const u32x4*)(Vb + off); }
}
__device__ __forceinline__ void tile_store(const TileRegs& t, MLAS unsigned char* wl, int lane) {
#pragma unroll
    for (int i = 0; i < 4; ++i) { const int id = lane + 64 * i, kk = id >> 3, ch = id & 7;
        *(MLAS u32x4*)(wl + kk * AK_STRIDE + ch * 16) = t.k[i]; *(MLAS u32x4*)(wl + AK_BYTES + kk * AV_STRIDE + ch * 16) = t.v[i]; }
}
template <int ND> __device__ __forceinline__ void softmax_step(f32x16& p, float& m, float& l, f32x16 (&o)[ND]) {
    float tm = p[0];
#pragma unroll
    for (int r = 1; r < 16; ++r) tm = fmaxf(tm, p[r]);
    tm = xhalf_max(tm);
    const float mn = fmaxf(m, tm);
    if (__any(mn > m)) {
        const float al = __builtin_amdgcn_exp2f(m - mn);
        l *= al;
#pragma unroll
        for (int d = 0; d < ND; ++d) o[d] = o[d] * al;
        m = mn;
    }
    float ps = 0.f;
#pragma unroll
    for (int r = 0; r < 16; ++r) { p[r] = __builtin_amdgcn_exp2f(p[r] - m); ps += p[r]; }
    l += ps;
}
__device__ __forceinline__ void load_vfrags(bf16x8 (&vf)[2][2], unsigned vb) {
    const s16x4 a0 = tr_read<0>(vb), a1 = tr_read<1536>(vb), b0 = tr_read<64>(vb), b1 = tr_read<1536 + 64>(vb);
    const s16x4 c0 = tr_read<3072>(vb), c1 = tr_read<3072 + 1536>(vb), d0 = tr_read<3072 + 64>(vb), d1 = tr_read<3072 + 1536 + 64>(vb);
    asm volatile("s_waitcnt lgkmcnt(0)" ::: "memory"); __builtin_amdgcn_sched_barrier(0);
#define PK_(L, H) (bf16x8){L[0], L[1], L[2], L[3], H[0], H[1], H[2], H[3]}
    vf[0][0] = PK_(a0, a1); vf[0][1] = PK_(b0, b1); vf[1][0] = PK_(c0, c1); vf[1][1] = PK_(d0, d1);
#undef PK_
}
__device__ __forceinline__ void pv_step(const f32x16& p, const bf16x8 (&vf)[2][2], f32x16 (&o)[2]) {
#pragma unroll
    for (int s = 0; s < 2; ++s) {
        u32x4 w; w.x = cvtpk(p[8 * s + 0], p[8 * s + 1]); w.y = cvtpk(p[8 * s + 2], p[8 * s + 3]); w.z = cvtpk(p[8 * s + 4], p[8 * s + 5]); w.w = cvtpk(p[8 * s + 6], p[8 * s + 7]);
        const bf16x8 pf = __builtin_bit_cast(bf16x8, w);
#pragma unroll
        for (int d = 0; d < 2; ++d) o[d] = __builtin_amdgcn_mfma_f32_32x32x16_bf16(vf[s][d], pf, o[d], 0, 0, 0);
    }
}
__device__ __forceinline__ unsigned vfrag_base(MLAS unsigned char* wl, int lane) {
    const int hh = lane >> 5;
    return (unsigned)(uintptr_t)(wl + AK_BYTES) + (unsigned)((4 * hh + ((lane & 15) >> 2)) * AV_STRIDE + (16 * ((lane >> 4) & 1) + 4 * (lane & 3)) * 2);
}
__device__ __forceinline__ void store_o(bf16_t* crow_ptr, const f32x16 (&o)[2], int hh) {
#pragma unroll
    for (int d = 0; d < 2; ++d)
#pragma unroll
        for (int g = 0; g < 4; ++g) { u32x2 w; w.x = cvtpk(o[d][4 * g], o[d][4 * g + 1]); w.y = cvtpk(o[d][4 * g + 2], o[d][4 * g + 3]);
            *(u32x2*)(crow_ptr + 32 * d + 8 * g + 4 * hh) = w; }
}

__device__ __forceinline__ void attnA_wave(const bf16_t* P, const float* lamv, const float* subln, bf16_t* concat, int bh, int q0, MLAS unsigned char* wl, int lane, int nrep) {
    const int hh = lane >> 5, b = bh >> 2, h = bh & 3;
    const bf16_t* Kb = P + 1 * TENS + (size_t)bh * SEQ * 64; const bf16_t* Vb = P + 2 * TENS + (size_t)bh * SEQ * 64;
    const bf16_t* qp = P + ((size_t)bh * SEQ + q0 + (lane & 31)) * 64 + hh * 8;
    bf16x8 qf[2][2];
#pragma unroll
    for (int c = 0; c < 2; ++c)
#pragma unroll
        for (int ds = 0; ds < 2; ++ds) qf[c][ds] = *(const bf16x8*)(qp + c * 32 + ds * 16);
    f32x16 o0[2], o1[2];
#pragma unroll
    for (int d = 0; d < 2; ++d)
#pragma unroll
        for (int r = 0; r < 16; ++r) { o0[d][r] = 0.f; o1[d][r] = 0.f; }
    float m0 = -1e30f, l0 = 0.f, m1 = -1e30f, l1 = 0.f;
    const unsigned vb = vfrag_base(wl, lane);
    const MLAS unsigned char* kfp = wl + (lane & 31) * AK_STRIDE + hh * 16;
    TileRegs tr; tile_load(tr, Kb, Vb, 0, 1, lane);
    for (int tt = 0; tt < (SEQ / 32) * nrep; ++tt) {
        tile_store(tr, wl, lane);
        if (tt + 1 < (SEQ / 32) * nrep) tile_load(tr, Kb, Vb, 32 * ((tt + 1) & 63), 1, lane);
        asm volatile("s_waitcnt lgkmcnt(0)" ::: "memory");
        f32x16 p0, p1;
#pragma unroll
        for (int r = 0; r < 16; ++r) { p0[r] = 0.f; p1[r] = 0.f; }
#pragma unroll
        for (int ds = 0; ds < 2; ++ds) {
            const bf16x8 k0 = *(const MLAS bf16x8*)(kfp + ds * 32), k1 = *(const MLAS bf16x8*)(kfp + 64 + ds * 32);
            p0 = __builtin_amdgcn_mfma_f32_32x32x16_bf16(k0, qf[0][ds], p0, 0, 0, 0);
            p1 = __builtin_amdgcn_mfma_f32_32x32x16_bf16(k1, qf[1][ds], p1, 0, 0, 0);
        }
        bf16x8 vf[2][2]; load_vfrags(vf, vb);
        softmax_step<2>(p0, m0, l0, o0);
        pv_step(p0, vf, o0);
        softmax_step<2>(p1, m1, l1, o1);
        pv_step(p1, vf, o1);
        asm volatile("s_waitcnt lgkmcnt(0)" ::: "memory");
    }
    l0 = xhalf_sum(l0); l1 = xhalf_sum(l1);
    const float r0 = 1.f / l0, r1 = lamv[0] / l1;
    float ss = 0.f;
#pragma unroll
    for (int d = 0; d < 2; ++d)
#pragma unroll
        for (int r = 0; r < 16; ++r) { const float v = o0[d][r] * r0 - o1[d][r] * r1; o0[d][r] = v; ss += v * v; }
    ss = xhalf_sum(ss);
    const float rs = 1.0f / sqrtf(ss * (1.f / 64.f) + EPS) * lamv[1];
#pragma unroll
    for (int d = 0; d < 2; ++d)
#pragma unroll
        for (int g = 0; g < 4; ++g) { const f32x4 sg = *(const f32x4*)(subln + 32 * d + 8 * g + 4 * hh);
#pragma unroll
            for (int k = 0; k < 4; ++k) o0[d][4 * g + k] = o0[d][4 * g + k] * rs * sg[k]; }
    store_o(concat + ((size_t)b * SEQ + q0 + (lane & 31)) * DM + h * 64, o0, hh);
}

__device__ __forceinline__ void attnB_wave(const bf16_t* P, const float* rpb_h, bf16_t* concat, int bh, int i, int jh, MLAS unsigned char* wl, MLAS float* tb, int lane, int nrep) {
    const int hh = lane >> 5, b = bh >> 2, h = bh & 3, j = 32 * jh + (lane & 31), s = i * 64 + j;
    const bf16_t* Kb = P + 4 * TENS + (size_t)bh * SEQ * 64; const bf16_t* Vb = P + 5 * TENS + (size_t)bh * SEQ * 64;
    const bf16_t* qp = P + 3 * TENS + ((size_t)bh * SEQ + s) * 64 + hh * 8;
    for (int idx = lane; idx < 15 * 32; idx += 64) { const int dr = idx >> 5, dc = idx & 31; tb[idx] = (dc < 31) ? rpb_h[dr * 31 + dc] * LOG2E : 0.f; }
    bf16x8 qf[4];
#pragma unroll
    for (int ds = 0; ds < 4; ++ds) qf[ds] = *(const bf16x8*)(qp + ds * 16);
    f32x16 o[2];
#pragma unroll
    for (int d = 0; d < 2; ++d)
#pragma unroll
        for (int r = 0; r < 16; ++r) o[d][r] = 0.f;
    float m = -1e30f, l = 0.f;
    const int rs = min(max(i - 4, 0), 24), cs = min(max(j - 8, 0), 48);
    const unsigned vb = vfrag_base(wl, lane);
    const MLAS unsigned char* kfp = wl + (lane & 31) * AK_STRIDE + hh * 16;
    TileRegs tr; tile_load(tr, Kb, Vb, rs * 64, 1, lane);
    for (int t2 = 0; t2 < 16 * nrep; ++t2) {
        const int tt = t2 & 15, tn = (t2 + 1) & 15;
        tile_store(tr, wl, lane);
        if (t2 + 1 < 16 * nrep) tile_load(tr, Kb, Vb, (rs + (tn >> 1)) * 64 + 32 * (tn & 1), 1, lane);
        asm volatile("s_waitcnt lgkmcnt(0)" ::: "memory");
        const int a = tt >> 1, ct = tt & 1, dr = rs + a - i + 7;
        f32x16 p;
#pragma unroll
        for (int r = 0; r < 16; ++r) p[r] = 0.f;
#pragma unroll
        for (int ds = 0; ds < 4; ++ds) { const bf16x8 kf = *(const MLAS bf16x8*)(kfp + ds * 32); p = __builtin_amdgcn_mfma_f32_32x32x16_bf16(kf, qf[ds], p, 0, 0, 0); }
        bf16x8 vf[2][2]; load_vfrags(vf, vb);
        const int c0 = 32 * ct + 4 * hh - cs;
        const MLAS float* tbr = tb + dr * 32 + (cs - j + 15);
#pragma unroll
        for (int r = 0; r < 16; ++r) { const int crel = c0 + (r & 3) + 8 * (r >> 2); const bool ok = (unsigned)crel < 16u;
            const float bias = tbr[ok ? crel : 0]; p[r] = ok ? p[r] + bias : -INFINITY; }
        softmax_step<2>(p, m, l, o);
        pv_step(p, vf, o);
        asm volatile("s_waitcnt lgkmcnt(0)" ::: "memory");
    }
    l = xhalf_sum(l);
    const float rl = 1.f / l;
#pragma unroll
    for (int d = 0; d < 2; ++d) o[d] = o[d] * rl;
    store_o(concat + ((size_t)b * SEQ + s) * DM + 256 + h * 64, o, hh);
}

__device__ __forceinline__ void attnD_wave(const bf16_t* P, bf16_t* concat, int bh, int u0, int rr, MLAS unsigned char* wl, int lane, int nrep) {
    const int hh = lane >> 5, b = bh >> 2, h = bh & 3, qi = lane & 31, t = rr + 16 * (u0 + qi);
    const bf16_t* Kb = P + 7 * TENS + (size_t)bh * SEQ * 64; const bf16_t* Vb = P + 8 * TENS + (size_t)bh * SEQ * 64;
    const bf16_t* qp = P + 6 * TENS + ((size_t)bh * SEQ + t) * 64 + hh * 8;
    bf16x8 qf[4];
#pragma unroll
    for (int ds = 0; ds < 4; ++ds) qf[ds] = *(const bf16x8*)(qp + ds * 16);
    f32x16 o[2];
#pragma unroll
    for (int d = 0; d < 2; ++d)
#pragma unroll
        for (int r = 0; r < 16; ++r) o[d][r] = 0.f;
    float m = -1e30f, l = 0.f;
    const int k1lo = max(0, u0 / 8 - 2), k1hi = min(15, u0 / 8 + 5), k0lo = max(0, u0 / 2 - 2), k0hi = min(63, u0 / 2 + 17);
    const int n2 = 4, n1 = k1hi - k1lo + 1, n0 = k0hi - k0lo + 1, nt = n2 + n1 + n0;
    const int pq2 = u0 + qi, pq1 = (rr >> 2) + 4 * (u0 + qi), pq0 = t;
    const unsigned vb = vfrag_base(wl, lane);
    const MLAS unsigned char* kfp = wl + (lane & 31) * AK_STRIDE + hh * 16;
#define DTILE(tt, tok0, strd, pbase, pq) do { if ((tt) < n2) { tok0 = rr + 512 * (tt); strd = 16; pbase = 32 * (tt); pq = pq2; } \
        else if ((tt) < n2 + n1) { const int kt_ = k1lo + (tt) - n2; tok0 = (rr & 3) + 128 * kt_; strd = 4; pbase = 32 * kt_; pq = pq1; } \
        else { const int kt_ = k0lo + (tt) - n2 - n1; tok0 = 32 * kt_; strd = 1; pbase = 32 * kt_; pq = pq0; } } while (0)
    TileRegs tr; { int tok0, strd, pbase, pq; DTILE(0, tok0, strd, pbase, pq); (void)pbase; (void)pq; tile_load(tr, Kb, Vb, tok0, strd, lane); }
    for (int t2 = 0; t2 < nt * nrep; ++t2) {
        const int tt = t2 >= nt ? t2 - nt : t2, tn = (t2 + 1 >= nt) ? t2 + 1 - nt : t2 + 1;
        tile_store(tr, wl, lane);
        if (t2 + 1 < nt * nrep) { int tok0, strd, pbase, pq; DTILE(tn, tok0, strd, pbase, pq); (void)pbase; (void)pq; tile_load(tr, Kb, Vb, tok0, strd, lane); }
        asm volatile("s_waitcnt lgkmcnt(0)" ::: "memory");
        int tok0, strd, pbase, pq; DTILE(tt, tok0, strd, pbase, pq); (void)tok0; (void)strd;
        f32x16 p;
#pragma unroll
        for (int r = 0; r < 16; ++r) p[r] = 0.f;
#pragma unroll
        for (int ds = 0; ds < 4; ++ds) { const bf16x8 kf = *(const MLAS bf16x8*)(kfp + ds * 32); p = __builtin_amdgcn_mfma_f32_32x32x16_bf16(kf, qf[ds], p, 0, 0, 0); }
        bf16x8 vf[2][2]; load_vfrags(vf, vb);
        const int dl = pbase + 4 * hh - pq + 64;
#pragma unroll
        for (int r = 0; r < 16; ++r) { const bool ok = (unsigned)(dl + (r & 3) + 8 * (r >> 2)) <= 128u; p[r] = ok ? p[r] : -INFINITY; }
        softmax_step<2>(p, m, l, o);
        pv_step(p, vf, o);
        asm volatile("s_waitcnt lgkmcnt(0)" ::: "memory");
    }
#undef DTILE
    l = xhalf_sum(l);
    const float rl = 1.f / l;
#pragma unroll
    for (int d = 0; d < 2; ++d) o[d] = o[d] * rl;
    store_o(concat + ((size_t)b * SEQ + t) * DM + 768 + h * 64, o, hh);
}

__device__ __forceinline__ void conv_tile(const bf16_t* Z, const float* w_dw, const float* b_dw, const float* g_n, const float* b_n, bf16_t* concat, int tile, MLAS unsigned char* lds, int tid) {
    const int t0 = tile * 64, b = t0 >> 11, s0 = t0 & 2047;
    MLAS unsigned* slab = (MLAS unsigned*)lds;
    for (int id = tid; id < 94 * 32; id += 512) { const int rw = id >> 5, ch = id & 31, sp = s0 - 15 + rw;
        u32x4 v = {0u, 0u, 0u, 0u}; if (sp >= 0 && sp < SEQ) v = *(const u32x4*)(Z + ((size_t)b * SEQ + sp) * 256 + ch * 8);
        *(MLAS u32x4*)(slab + rw * 128 + ch * 4) = v; }
    __syncthreads();
    const int cp = tid & 127, tb = tid >> 7;
    unsigned zr[46];
#pragma unroll
    for (int k = 0; k < 46; ++k) zr[k] = slab[(16 * tb + k) * 128 + cp];
    float a0[16], a1[16];
    { const float bb0 = b_dw[2 * cp], bb1 = b_dw[2 * cp + 1];
#pragma unroll
      for (int t = 0; t < 16; ++t) { a0[t] = bb0; a1[t] = bb1; } }
#pragma unroll
    for (int k = 0; k < 31; ++k) { const float w0 = w_dw[k * 256 + 2 * cp], w1 = w_dw[k * 256 + 2 * cp + 1];
#pragma unroll
        for (int t = 0; t < 16; ++t) { a0[t] += bflo(zr[t + k]) * w0; a1[t] += bfhi(zr[t + k]) * w1; } }
    const float gn0 = g_n[2 * cp], gn1 = g_n[2 * cp + 1], bn0 = b_n[2 * cp], bn1 = b_n[2 * cp + 1];
#pragma unroll
    for (int t = 0; t < 16; ++t) {
        float sm = a0[t] + a1[t];
#pragma unroll
        for (int o = 1; o < 32; o <<= 1) sm += __shfl_xor(sm, o);
        const float mu = sm * (1.f / 64.f), d0 = a0[t] - mu, d1 = a1[t] - mu;
        float q = d0 * d0 + d1 * d1;
#pragma unroll
        for (int o = 1; o < 32; o <<= 1) q += __shfl_xor(q, o);
        const float rstd = 1.0f / sqrtf(q * (1.f / 64.f) + EPS);
        const float y0 = silu_f(d0 * rstd * gn0 + bn0), y1 = silu_f(d1 * rstd * gn1 + bn1);
        *(unsigned*)(concat + (size_t)(t0 + 16 * tb + t) * DM + 512 + 2 * cp) = cvtpk(y0, y1);
    }
    __syncthreads();
}

#define LAS __attribute__((address_space(3)))
#define GAS __attribute__((address_space(1)))
#define LDS_WAIT() asm volatile("s_waitcnt lgkmcnt(0)" ::: "memory")
#define VM_WAIT() asm volatile("s_waitcnt vmcnt(0)" ::: "memory")
constexpr int NWAVES = 8, NTHREADS = 512;
constexpr int RING_BYTES = 131072, LDSX_OFF = RING_BYTES, LDS_BYTES = 147456;
constexpr int LX_BAR = 0, LX_TSTART = 64, LX_CNT = 256, LX_HIST = 512, LX_BASE = 640, LX_AE = 768, LX_ALR = 1280;
constexpr size_t OFF_WIN = 2 * MiB, OFF_WOUT = 14 * MiB, OFF_W1 = 18 * MiB, OFF_W2 = 146 * MiB;
constexpr int CW_BAR = 8192;
static_assert((CW_BAR + 3456) * 4 <= (int)CTL_BYTES, "ctl region");
constexpr float SCALE_A = 0.17677669529663687f * LOG2E, SCALE_64 = 0.125f * LOG2E;

#define XB_TMO      128
#define XB_XCNT(j)  (256  + 64 * (j))
#define XB_XSUB(j)  (1280 + 64 * (j))
#define XB_XGEN(j)  (2304 + 64 * (j))
#define XB_TOP      3328
#define XB_TOPGEN   3392
#define XCD_BAR_WORDS 3456
#define XB_SPIN_CAP (1u << 18)
__device__ __forceinline__ unsigned xb_ld(unsigned* p)              { return __hip_atomic_load(p, __ATOMIC_RELAXED, __HIP_MEMORY_SCOPE_AGENT); }
__device__ __forceinline__ unsigned xb_add(unsigned* p, unsigned v) { return __hip_atomic_fetch_add(p, v, __ATOMIC_RELAXED, __HIP_MEMORY_SCOPE_AGENT); }
__device__ __forceinline__ unsigned xb_xcc_id() { return (unsigned)__builtin_amdgcn_s_getreg((3 << 11) | 20) & 0xFu; }
#define XB_SPIN(cond, bar) do { unsigned _sp = 0; while (cond) { __builtin_amdgcn_s_sleep(1); \
    if ((++_sp & 255u) == 0u) { if (xb_ld(&(bar)[XB_TMO])) break; if (_sp > XB_SPIN_CAP) { atomicAdd(&(bar)[XB_TMO], 1u); break; } } } } while (0)
struct XcdBarrier { unsigned* bar; unsigned x; volatile LAS unsigned* st; };
__device__ __forceinline__ XcdBarrier xcd_barrier_post(unsigned* bar, volatile LAS unsigned* st) {
    XcdBarrier b; b.bar = bar; b.x = xb_xcc_id(); b.st = st;
    if (threadIdx.x == 0) (void)xb_add(&bar[XB_XCNT(b.x)], 1u);
    return b;
}
__device__ __forceinline__ void xcd_barrier_complete(unsigned* bar, unsigned x, unsigned& nloc, unsigned& nx) {
    const unsigned G = gridDim.x * gridDim.y * gridDim.z;
    unsigned sum, cnt, mine, sp = 0u;
    for (;;) {
        sum = 0u; cnt = 0u; mine = 0u;
#pragma unroll
        for (unsigned j = 0; j < 16; ++j) { const unsigned c = xb_ld(&bar[XB_XCNT(j)]); sum += c; cnt += (c > 0u) ? 1u : 0u; mine = (j == x) ? c : mine; }
        if (sum == G) break;
        __builtin_amdgcn_s_sleep(1);
        if ((++sp & 255u) == 0u) { if (xb_ld(&bar[XB_TMO])) break; if (sp > XB_SPIN_CAP) { atomicAdd(&bar[XB_TMO], 1u); break; } }
    }
    nloc = mine > 0u ? mine : 1u; nx = cnt > 0u ? cnt : 1u;
}
__device__ __forceinline__ void xcd_barrier(const XcdBarrier& b) {
    asm volatile("s_waitcnt vmcnt(0)" ::: "memory");
    __syncthreads();
    if (threadIdx.x == 0) {
        unsigned* bar = b.bar;
        __builtin_amdgcn_s_waitcnt(0);
        unsigned nloc = b.st[0], nx = b.st[1];
        if (nloc == 0u) { xcd_barrier_complete(bar, b.x, nloc, nx); b.st[0] = nloc; b.st[1] = nx; }
        const unsigned old = xb_add(&bar[XB_XSUB(b.x)], 1u);
        const unsigned gen = old / nloc;
        if (old + 1u == (gen + 1u) * nloc) {
            __builtin_amdgcn_fence(__ATOMIC_RELEASE, "agent");
            asm volatile("s_waitcnt vmcnt(0)" ::: "memory");
            const unsigned og = xb_add(&bar[XB_TOP], 1u);
            const unsigned tg = og / nx;
            if (og + 1u == (tg + 1u) * nx) xb_add(&bar[XB_TOPGEN], 1u);
            else XB_SPIN(xb_ld(&bar[XB_TOPGEN]) == tg, bar);
            __builtin_amdgcn_fence(__ATOMIC_ACQUIRE, "agent");
            xb_add(&bar[XB_XGEN(b.x)], 1u);
            asm volatile("s_waitcnt vmcnt(0)" ::: "memory");
        } else {
            XB_SPIN(xb_ld(&bar[XB_XGEN(b.x)]) == gen, bar);
            __builtin_amdgcn_fence(__ATOMIC_ACQUIRE, "agent");
            asm volatile("s_waitcnt vmcnt(0)" ::: "memory");
        }
    }
    __syncthreads();
}

__device__ __forceinline__ u32x4 pack8(pg8::f32x4 a, pg8::f32x4 b) {
    u32x4 w; w.x = pg8::cvt_pk_bf16(a[0], a[1]); w.y = pg8::cvt_pk_bf16(a[2], a[3]); w.z = pg8::cvt_pk_bf16(b[0], b[1]); w.w = pg8::cvt_pk_bf16(b[2], b[3]); return w;
}
struct EpiProj {
    static constexpr bool PERM = true, AFTER_DRAIN = false;
    bf16_t* P; const float* rot;
    __device__ __forceinline__ void operator()(const pg8::f32x4 (&acc)[2][2][4][2], const pg8::Unit& u, int wr, int wc, int fr, int fq) const {
        const int pn = u.pn;
        const float* cos64 = rot; const float* sin64 = rot + 2048 * 32; const float* cos32 = rot + 2 * 2048 * 32; const float* sin32 = cos32 + 2048 * 16;
#pragma unroll
        for (int ai = 0; ai < 2; ++ai)
#pragma unroll
            for (int m = 0; m < 4; ++m) {
                const int row = u.pm * 256 + ai * 128 + wr * 64 + m * 16 + fr, b = row >> 11, s = row & 2047;
                if (pn == 6 || pn == 7) {
                    const int ch = (pn - 6) * 128 + wc * 32 + 8 * fq;
                    pg8::f32x4 z0, z1;
#pragma unroll
                    for (int k = 0; k < 4; ++k) { z0[k] = acc[ai][0][m][0][k] / (1.f + __expf(-acc[ai][1][m][0][k])); z1[k] = acc[ai][0][m][1][k] / (1.f + __expf(-acc[ai][1][m][1][k])); }
                    *(u32x4*)(P + 9 * TENS + (size_t)row * 256 + ch) = pack8(z0, z1);
                } else {
#pragma unroll
                    for (int bj = 0; bj < 2; ++bj) {
                        const int c8 = bj * 128 + wc * 32 + 8 * fq, h = c8 >> 6, e = c8 & 63;
                        pg8::f32x4 v0 = acc[ai][bj][m][0], v1 = acc[ai][bj][m][1];
                        int tens = pn;
                        if (pn <= 1 || pn == 8 || pn == 9) {
                            pg8::f32x4 cs, sn;
                            if (pn <= 1) { const int i0 = (e & 31) >> 1; cs = *(const pg8::f32x4*)(cos32 + s * 16 + i0); sn = *(const pg8::f32x4*)(sin32 + s * 16 + i0); }
                            else { const int i0 = e >> 1; cs = *(const pg8::f32x4*)(cos64 + s * 32 + i0); sn = *(const pg8::f32x4*)(sin64 + s * 32 + i0); tens = pn - 2; }
                            const pg8::f32x4 a = v0, c = v1;
                            v0[0] = a[0] * cs[0] - a[1] * sn[0]; v0[1] = a[1] * cs[0] + a[0] * sn[0]; v0[2] = a[2] * cs[1] - a[3] * sn[1]; v0[3] = a[3] * cs[1] + a[2] * sn[1];
                            v1[0] = c[0] * cs[2] - c[1] * sn[2]; v1[1] = c[1] * cs[2] + c[0] * sn[2]; v1[2] = c[2] * cs[3] - c[3] * sn[3]; v1[3] = c[3] * cs[3] + c[2] * sn[3];
                        } else if (pn == 10) tens = 8;
                        const float sc = (pn == 0) ? SCALE_A : ((pn == 3 || pn == 8) ? SCALE_64 : 1.f);
                        v0 = v0 * sc; v1 = v1 * sc;
                        *(u32x4*)(P + (size_t)tens * TENS + (((size_t)b * 4 + h) * SEQ + s) * 64 + e) = pack8(v0, v1);
                    }
                }
            }
    }
};
struct EpiOut {
    static constexpr bool PERM = true, AFTER_DRAIN = false;
    const float* xin; const float* modl; float* out;
    __device__ __forceinline__ void operator()(const pg8::f32x4 (&acc)[2][2][4][2], const pg8::Unit& u, int wr, int wc, int fr, int fq) const {
#pragma unroll
        for (int ai = 0; ai < 2; ++ai)
#pragma unroll
            for (int m = 0; m < 4; ++m) {
                const int row = u.pm * 256 + ai * 128 + wr * 64 + m * 16 + fr, b = row >> 11;
#pragma unroll
                for (int bj = 0; bj < 2; ++bj) {
                    const int col = u.pn * 256 + bj * 128 + wc * 32 + 8 * fq;
                    const float* gp = modl + (size_t)b * 6144 + 2048 + col; const float* xp = xin + (size_t)row * DM + col; float* op = out + (size_t)row * DM + col;
                    *(pg8::f32x4*)op = *(const pg8::f32x4*)xp + *(const pg8::f32x4*)gp * acc[ai][bj][m][0];
                    *(pg8::f32x4*)(op + 4) = *(const pg8::f32x4*)(xp + 4) + *(const pg8::f32x4*)(gp + 4) * acc[ai][bj][m][1];
                }
            }
    }
};
struct EpiGUm {
    static constexpr bool PERM = true, AFTER_DRAIN = false;
    bf16_t* hdn;
    __device__ __forceinline__ void operator()(const pg8::f32x4 (&acc)[2][2][4][2], const pg8::Unit& u, int wr, int wc, int fr, int fq) const {
#pragma unroll
        for (int ai = 0; ai < 2; ++ai)
#pragma unroll
            for (int m = 0; m < 4; ++m) {
                const int row = u.pm * 256 + ai * 128 + wr * 64 + m * 16 + fr, col = (u.pn & 3) * 128 + wc * 32 + 8 * fq;
                pg8::f32x4 z0, z1;
#pragma unroll
                for (int k = 0; k < 4; ++k) { const float g0 = acc[ai][0][m][0][k], g1 = acc[ai][0][m][1][k];
                    z0[k] = g0 / (1.f + __expf(-g0)) * acc[ai][1][m][0][k]; z1[k] = g1 / (1.f + __expf(-g1)) * acc[ai][1][m][1][k]; }
                *(u32x4*)(hdn + (size_t)row * DE + col) = pack8(z0, z1);
            }
    }
};
struct EpiYm {
    static constexpr bool PERM = true, AFTER_DRAIN = false;
    bf16_t* y;
    __device__ __forceinline__ void operator()(const pg8::f32x4 (&acc)[2][2][4][2], const pg8::Unit& u, int wr, int wc, int fr, int fq) const {
#pragma unroll
        for (int ai = 0; ai < 2; ++ai)
#pragma unroll
            for (int m = 0; m < 4; ++m) {
                const int row = u.pm * 256 + ai * 128 + wr * 64 + m * 16 + fr;
#pragma unroll
                for (int bj = 0; bj < 2; ++bj) { const int col = (u.pn & 3) * 256 + bj * 128 + wc * 32 + 8 * fq;
                    *(u32x4*)(y + (size_t)row * DM + col) = pack8(acc[ai][bj][m][0], acc[ai][bj][m][1]); }
            }
    }
};
struct MoeOrder {
    const LAS int* tstart; int G, c; const LAS int* cnt; const int* etok;
    __device__ __forceinline__ unsigned row_off(const pg8::Unit& u, int r) const {
        const int e = u.pn >> 2, idx = (u.pm - tstart[e]) * 256 + r;
        const int tok = (idx < cnt[e]) ? etok[e * T + idx] : 0;
        return (unsigned)tok * (unsigned)(DM * 2);
    }
    __device__ __forceinline__ bool next(int i, pg8::Unit& u) const {
        const int L = i * G + c, ntile = tstart[NE];
        if (L >= ntile * 4) return false;
        const int tl = L >> 2; int e = 0;
#pragma unroll 1
        for (int k = 1; k < NE; ++k) e += (tstart[k] <= tl) ? 1 : 0;
        u.pm = tl; u.pn = e * 4 + (L & 3); return true;
    }
    __device__ __forceinline__ void a_ready(const pg8::Unit&) const {}
    __device__ __forceinline__ void done(const pg8::Unit&) const {}
};

template <class RM>
__device__ __forceinline__ void transpose_item(const float* W, int K, int N, bf16_t* WT, RM rm, LAS float* scr, int item, int lane) {
    const int nblk = N / 32, kb = item / nblk, nb = item % nblk, k0 = 64 * kb, n0 = 32 * nb;
#pragma unroll 8
    for (int i = 0; i < 32; ++i) { const int kk = 2 * i + (lane >> 5); scr[kk * 33 + (lane & 31)] = W[(size_t)(k0 + kk) * N + n0 + (lane & 31)]; }
    LDS_WAIT(); asm volatile("" ::: "memory");
    const int c = lane & 7;
#pragma unroll
    for (int j = 0; j < 4; ++j) { const int n = (lane >> 3) + 8 * j; const LAS float* s = scr + (8 * c) * 33 + n;
        u32x4 o; o.x = pk2(s[0 * 33], s[1 * 33]); o.y = pk2(s[2 * 33], s[3 * 33]); o.z = pk2(s[4 * 33], s[5 * 33]); o.w = pk2(s[6 * 33], s[7 * 33]);
        *(u32x4*)(WT + (size_t)rm(n0 + n) * K + k0 + 8 * c) = o; }
    LDS_WAIT(); asm volatile("" ::: "memory");
}
struct RmId { __device__ __forceinline__ int operator()(int n) const { return n; } };
struct RmGate { int up; __device__ __forceinline__ int operator()(int n) const { return (n >> 7) * 256 + up * 128 + (n & 127); } };
struct RmIn { __device__ __forceinline__ int operator()(int n) const {
    if (n < 512) { const int pn = n >> 8, r = n & 255, h = r >> 6, e = r & 63, cm = e >> 5, el = e & 31, i = el & 15, odd = el >> 4; return pn * 256 + h * 64 + cm * 32 + 2 * i + odd; }
    if (n < 1536) return n;
    if (n < 1792) { const int ch = n - 1536; return (6 + (ch >> 7)) * 256 + (ch & 127); }
    if (n < 2048) { const int ch = n - 1792; return (6 + (ch >> 7)) * 256 + 128 + (ch & 127); }
    if (n < 2560) { const int q = n - 2048, pn = 8 + (q >> 8), r = q & 255, h = r >> 6, e = r & 63, i = e & 31, odd = e >> 5; return pn * 256 + h * 64 + 2 * i + odd; }
    return n; } };

struct Args { const float* in[21]; float* out; unsigned char* ws; int ph_lo, ph_hi; };
constexpr int PH_PRO = 0, PH_NORM = 1, PH_L0 = 2, NPL = 8, NPH = PH_L0 + NPL * DEPTH;

#ifndef PROBE_KIND
#define PROBE_KIND -1
#endif
#ifndef PROBE_N
#define PROBE_N 2
#endif
#define REP_(k) for (int rep_ = 0; rep_ < ((PROBE_KIND == (k)) ? PROBE_N : 1); ++rep_)
typedef const __attribute__((address_space(4))) Args* KArgs;
__device__ __forceinline__ KArgs kargs() { KArgs p = (KArgs)__builtin_amdgcn_kernarg_segment_ptr(); asm volatile("" : "+s"(p)); return p; }
#define PH_BEGIN KArgs ka = kargs(); int tid = threadIdx.x; asm volatile("" : "+v"(tid)); const int lane = tid & 63, wave = __builtin_amdgcn_readfirstlane(tid >> 6); \
    unsigned char* ws = ka->ws; const int gw = bx * NWAVES + wave, NGW = G * NWAVES; (void)lane; (void)gw; (void)NGW; (void)ws; \
    LAS unsigned char* lds = (LAS unsigned char*)lds_raw; LAS unsigned char* ldx = lds + LDSX_OFF; (void)ldx;
#define WS_PTRS unsigned* ctl = (unsigned*)(ws + OFF_CTL); float* mod = (float*)(ws + OFF_MOD); float* rot = (float*)(ws + OFF_ROT); float* lamv = (float*)(ws + OFF_LAM); \
    int* eid = (int*)(ws + OFF_ROUTE); float* gate = (float*)(ws + OFF_ROUTE + 128 * 1024); int* rank = (int*)(ws + OFF_ROUTE + 256 * 1024); int* etok = (int*)(ws + OFF_ET); \
    float* X1 = (float*)(ws + OFF_X1); float* X2 = (float*)(ws + OFF_X2); bf16_t* H = (bf16_t*)(ws + OFF_H); \
    bf16_t* P = (bf16_t*)(ws + OFF_P); bf16_t* Y = P; bf16_t* CC = (bf16_t*)(ws + OFF_C); bf16_t* HDN = CC; \
    bf16_t* WIN = (bf16_t*)(ws + OFF_WIN); bf16_t* WOUT = (bf16_t*)(ws + OFF_WOUT); bf16_t* W1 = (bf16_t*)(ws + OFF_W1); bf16_t* W2 = (bf16_t*)(ws + OFF_W2); \
    const float* modl = mod + (size_t)l * BATCH * 6144; const float* xin = (l == 0) ? ka->in[0] : X2; unsigned* gcnt = ctl + CW_CNT + l * 64; \
    (void)ctl; (void)mod; (void)rot; (void)lamv; (void)eid; (void)gate; (void)rank; (void)etok; (void)X1; (void)X2; (void)H; (void)P; (void)Y; (void)CC; (void)HDN; \
    (void)WIN; (void)WOUT; (void)W1; (void)W2; (void)modl; (void)xin; (void)gcnt;

__global__ void __launch_bounds__(NTHREADS, 2) mk_fwd(Args args) {
    extern __shared__ __attribute__((aligned(16))) unsigned char lds_raw[];
    const int G = gridDim.x, bx = blockIdx.x;
    const int lo = args.ph_lo, hi = args.ph_hi;
    XcdBarrier bar;
    {
        LAS unsigned char* ldx0 = (LAS unsigned char*)lds_raw + LDSX_OFF;
        if (threadIdx.x < 16) ((LAS unsigned*)ldx0)[threadIdx.x] = 0u;
        __syncthreads();
        unsigned* ctl0 = (unsigned*)(args.ws + OFF_CTL);
        bar.bar = ctl0 + CW_BAR; bar.x = 0; bar.st = (volatile LAS unsigned*)(ldx0 + LX_BAR);
        if (hi - lo > 1) bar = xcd_barrier_post(ctl0 + CW_BAR, (volatile LAS unsigned*)(ldx0 + LX_BAR));
    }
#define IN(k) (lo <= (k) && (k) < hi)
#define SEAM(k) do { if (IN(k) && IN((k) + 1)) { REP_(12) xcd_barrier(bar); } } while (0)

    if (IN(PH_PRO)) REP_(0) {
        const int l = 0; PH_BEGIN WS_PTRS
        {
            float* cos64 = rot; float* sin64 = rot + 2048 * 32; float* cos32 = rot + 2 * 2048 * 32; float* sin32 = cos32 + 2048 * 16;
            for (int idx = bx * NTHREADS + tid; idx < 2048 * 32; idx += G * NTHREADS) {
                const int pos = idx >> 5, i = idx & 31;
                { const double inv = pow(10000.0, -(double)i / 32.0), a = (double)pos * inv; cos64[idx] = (float)cos(a); sin64[idx] = (float)sin(a); }
                if (i < 16) { const double inv = pow(10000.0, -(double)i / 16.0), a = (double)pos * inv; cos32[pos * 16 + i] = (float)cos(a); sin32[pos * 16 + i] = (float)sin(a); }
            }
            {
                float* rt = (float*)(ws + OFF_RT);
                for (int idx = bx * NTHREADS + tid; idx < DEPTH * 36864; idx += G * NTHREADS) {
                    const int ll = idx / 36864, r = idx % 36864, d = r & 1023, o = r >> 10;
                    rt[idx] = (o < 4) ? ka->in[15][((size_t)ll * DM + d) * 4 + o] : ka->in[16][(((size_t)ll * 4 + ((o - 4) >> 3)) * DM + d) * 8 + ((o - 4) & 7)];
                }
            }
            if (bx == 0 && tid < DEPTH) {
                const float* lp = ka->in[7] + tid * 4 * 32; float s01 = 0.f, s23 = 0.f;
                for (int e = 0; e < 32; ++e) { s01 += lp[e] * lp[32 + e]; s23 += lp[64 + e] * lp[96 + e]; }
                const float lam_init = 0.8f - 0.6f * expf(-0.3f * (float)tid);
                lamv[2 * tid] = expf(s01) - expf(s23) + lam_init; lamv[2 * tid + 1] = 1.f - lam_init;
            }
        }
        {
            LAS float* ca = (LAS float*)lds; LAS float* red = (LAS float*)(lds + 32768);
            const float* c = ka->in[1]; const float* w_ada = ka->in[2]; const float* b_ada = ka->in[3];
            for (int unit = bx; unit < DEPTH * 96; unit += G) {
                const int l = unit / 96, n0 = (unit % 96) * 64;
                __syncthreads();
                for (int i = tid; i < BATCH * DM; i += NTHREADS) ca[i] = silu_f(c[i]);
                __syncthreads();
                float acc[BATCH];
#pragma unroll
                for (int b = 0; b < BATCH; ++b) acc[b] = 0.f;
                const float* wp = w_ada + ((size_t)l * DM + wave * 128) * 6144 + n0 + lane;
                for (int dd = 0; dd < 128; ++dd) { const float w = wp[(size_t)dd * 6144];
#pragma unroll
                    for (int b = 0; b < BATCH; ++b) acc[b] += ca[b * DM + wave * 128 + dd] * w; }
#pragma unroll
                for (int b = 0; b < BATCH; ++b) red[(wave * BATCH + b) * 64 + lane] = acc[b];
                __syncthreads();
                { const int b = tid >> 6; float s = b_ada[l * 6144 + n0 + lane];
#pragma unroll
                  for (int k = 0; k < NWAVES; ++k) s += red[(k * BATCH + b) * 64 + lane];
                  mod[((size_t)l * BATCH + b) * 6144 + n0 + lane] = s; }
            }
            __syncthreads();
        }
        {
            LAS float* scr = (LAS float*)(lds + wave * 16384);
            constexpr int I_IN = 16 * 88, I_OUT = 16 * 32, I_G = 32 * 256, I_D = 32 * 256, I_L = I_IN + I_OUT + 2 * I_G + I_D;
            for (int it = gw; it < DEPTH * I_L; it += NGW) {
                const int l = it / I_L; int r = it % I_L;
                if (r < I_IN) { transpose_item(ka->in[6] + (size_t)l * DM * P_IN, DM, P_IN, WIN + (size_t)l * P_IN * DM, RmIn{}, scr, r, lane); continue; } r -= I_IN;
                if (r < I_OUT) { transpose_item(ka->in[14] + (size_t)l * DM * DM, DM, DM, WOUT + (size_t)l * DM * DM, RmId{}, scr, r, lane); continue; } r -= I_OUT;
                if (r < I_G) { const int e = r >> 8; transpose_item(ka->in[17] + ((size_t)l * NE + e) * DM * DE, DM, DE, W1 + ((size_t)l * NE + e) * 1024 * DM, RmGate{0}, scr, r & 255, lane); continue; } r -= I_G;
                if (r < I_G) { const int e = r >> 8; transpose_item(ka->in[18] + ((size_t)l * NE + e) * DM * DE, DM, DE, W1 + ((size_t)l * NE + e) * 1024 * DM, RmGate{1}, scr, r & 255, lane); continue; } r -= I_G;
                { const int e = r >> 8; transpose_item(ka->in[19] + ((size_t)l * NE + e) * DE * DM, DE, DM, W2 + ((size_t)l * NE + e) * DM * DE, RmId{}, scr, r & 255, lane); }
            }
        }
    }
    SEAM(PH_PRO);
    if (IN(PH_NORM)) REP_(1) {
        const int l = 0; PH_BEGIN WS_PTRS
        const float* x = ka->in[0];
        for (int row = gw; row < T; row += NGW) {
            f32x4 v[4]; load_row(x + (size_t)row * DM, lane, v);
            const float* m = mod + (size_t)(row >> 11) * 6144;
            norm_mod_row(v, ka->in[4], m + 1024, m, lane);
            store_row_bf16(H + (size_t)row * DM, lane, v);
        }
    }
    SEAM(PH_NORM);
    for (int l = 0; l < DEPTH; ++l) {
        const int pb = PH_L0 + NPL * l;
        if (IN(pb + 0)) REP_(2) {
            PH_BEGIN WS_PTRS
            pg8::Gemm g{H, WIN + (size_t)l * P_IN * DM, T, P_IN, DM}; pg8::StaticOrder S; S.init(T, P_IN, G, bx);
            EpiProj E{P, rot};
            pg8::gemm_phase<EpiProj, pg8::StaticOrder, true, true>(lds, g, S, E);
        }
        SEAM(pb + 0);
        if (IN(pb + 1)) {
            PH_BEGIN WS_PTRS
            MLAS unsigned char* wl = lds + wave * AW_BYTES;
            for (int u = bx; u < 256; u += G) {
                attnA_wave(P, lamv + 2 * l, ka->in[8] + l * 64, CC, u >> 3, (u & 7) * 256 + wave * 32, wl, lane, (PROBE_KIND == 3) ? PROBE_N : 1);
                attnB_wave(P, ka->in[9] + ((size_t)l * 4 + ((u >> 3) & 3)) * 15 * 31, CC, u >> 3, 4 * (u & 7) + (wave >> 1), wave & 1, wl, (MLAS float*)(lds + AB_OFF + wave * AB_BYTES), lane, (PROBE_KIND == 4) ? PROBE_N : 1);
                attnD_wave(P, CC, u >> 3, 32 * ((u >> 1) & 3), 8 * (u & 1) + wave, wl, lane, (PROBE_KIND == 5) ? PROBE_N : 1);
            }
            __syncthreads();
            for (int u = bx; u < 256; u += G) REP_(13)
                conv_tile(P + 9 * TENS, ka->in[10] + l * 31 * 256, ka->in[11] + l * 256, ka->in[12] + l * 256, ka->in[13] + l * 256, CC, u, lds, tid);
        }
        SEAM(pb + 1);
        if (IN(pb + 2)) REP_(6) {
            PH_BEGIN WS_PTRS
            pg8::Gemm g{CC, WOUT + (size_t)l * DM * DM, T, DM, DM}; pg8::StaticOrder S; S.init(T, DM, G, bx);
            EpiOut E{xin, modl, X1};
            pg8::gemm_phase<EpiOut, pg8::StaticOrder, true, true>(lds, g, S, E);
        }
        SEAM(pb + 2);
        if (IN(pb + 3)) {
            PH_BEGIN WS_PTRS
            LAS int* hist = (LAS int*)(ldx + LX_HIST); LAS int* basee = (LAS int*)(ldx + LX_BASE); LAS int* a_e = (LAS int*)(ldx + LX_AE); LAS int* a_lr = (LAS int*)(ldx + LX_ALR);
            const float* g2 = ka->in[5] + l * DM;
            const float* wrgT = (const float*)(ws + OFF_RT) + (size_t)l * 36864; const float* wreT = wrgT + 4096;
            {
                LAS f32x4* wl4 = (LAS f32x4*)lds;
                for (int i = tid; i < 8192; i += NTHREADS) wl4[i] = *(const f32x4*)(wreT + 4 * i);
            }
            for (int chunk = bx; chunk < T / 64; chunk += G) {
                __syncthreads();
                if (tid < NE) hist[tid] = 0;
                __syncthreads();
                const float* m = modl + (size_t)((chunk * 64) >> 11) * 6144;
                f32x4 pa[4], pb2[4];
#pragma unroll
                for (int j = 0; j < 4; ++j) { const f32x4 gg = *(const f32x4*)(g2 + 256 * j + 4 * lane), sc = *(const f32x4*)(m + 4 * 1024 + 256 * j + 4 * lane);
                    pa[j] = gg * (1.f + sc); pb2[j] = *(const f32x4*)(m + 3 * 1024 + 256 * j + 4 * lane); }
                constexpr int RB = 2;
                REP_(7) for (int it = 0; it < 8; it += RB) {
                    const int lr0 = wave * 8 + it, row0 = chunk * 64 + lr0;
                    f32x4 v[RB][4]; float ssq[RB];
#pragma unroll
                    for (int r = 0; r < RB; ++r) load_row(X1 + (size_t)(row0 + r) * DM, lane, v[r]);
#pragma unroll
                    for (int r = 0; r < RB; ++r) { float a = 0.f;
#pragma unroll
                        for (int j = 0; j < 4; ++j) a += (v[r][j].x * v[r][j].x + v[r][j].y * v[r][j].y) + (v[r][j].z * v[r][j].z + v[r][j].w * v[r][j].w);
                        ssq[r] = a; }
#pragma unroll
                    for (int r = 0; r < RB; ++r) ssq[r] = wave_sum(ssq[r]);
                    float lg[RB][4];
#pragma unroll
                    for (int r = 0; r < RB; ++r) { const float rstd = 1.0f / sqrtf(ssq[r] * (1.f / DM) + EPS);
#pragma unroll
                        for (int j = 0; j < 4; ++j) v[r][j] = v[r][j] * rstd * pa[j] + pb2[j];
                        store_row_bf16(H + (size_t)(row0 + r) * DM, lane, v[r]);
#pragma unroll
                        for (int g = 0; g < 4; ++g) lg[r][g] = 0.f; }
#pragma unroll
                    for (int j = 0; j < 4; ++j)
#pragma unroll
                        for (int g = 0; g < 4; ++g) { const f32x4 w = *(const f32x4*)(wrgT + g * 1024 + 256 * j + 4 * lane);
#pragma unroll
                            for (int r = 0; r < RB; ++r) lg[r][g] += (v[r][j].x * w.x + v[r][j].y * w.y) + (v[r][j].z * w.z + v[r][j].w * w.w); }
#pragma unroll
                    for (int r = 0; r < RB; ++r)
#pragma unroll
                        for (int g = 0; g < 4; ++g) lg[r][g] = wave_sum(lg[r][g]);
                    int grp[RB]; float p_grp[RB]; float le[RB][8];
#pragma unroll
                    for (int r = 0; r < RB; ++r) { int gi = 0; float best = lg[r][0];
#pragma unroll
                        for (int g = 1; g < 4; ++g) if (lg[r][g] > best) { best = lg[r][g]; gi = g; }
                        float den = 0.f;
#pragma unroll
                        for (int g = 0; g < 4; ++g) den += expf(lg[r][g] - best);
                        grp[r] = gi; p_grp[r] = 1.f / den; }
#pragma unroll
                    for (int e = 0; e < 8; ++e)
#pragma unroll
                        for (int r = 0; r < RB; ++r) { const LAS float* wre = (const LAS float*)lds + (grp[r] * 8 + e) * 1024 + 4 * lane; float a = 0.f;
#pragma unroll
                            for (int j = 0; j < 4; ++j) { const f32x4 w = *(const LAS f32x4*)(wre + 256 * j); a += (v[r][j].x * w.x + v[r][j].y * w.y) + (v[r][j].z * w.z + v[r][j].w * w.w); }
                            le[r][e] = a; }
#pragma unroll
                    for (int r = 0; r < RB; ++r)
#pragma unroll
                        for (int e = 0; e < 8; ++e) le[r][e] = wave_sum(le[r][e]);
#pragma unroll
                    for (int r = 0; r < RB; ++r) {
                        int i0 = 0; float v0 = le[r][0];
#pragma unroll
                        for (int e = 1; e < 8; ++e) if (le[r][e] > v0) { v0 = le[r][e]; i0 = e; }
                        int i1 = -1; float v1 = -3.0e38f;
#pragma unroll
                        for (int e = 0; e < 8; ++e) if (e != i0 && le[r][e] > v1) { v1 = le[r][e]; i1 = e; }
                        const float e1 = expf(v1 - v0), gt0 = p_grp[r] / (1.f + e1), gt1 = p_grp[r] * e1 / (1.f + e1);
                        if (lane == 0 && rep_ == 0) {
                            const int ea = grp[r] * 8 + i0, eb = grp[r] * 8 + i1, row = row0 + r, lr = lr0 + r;
                            eid[row * 2] = ea; eid[row * 2 + 1] = eb; gate[row * 2] = gt0; gate[row * 2 + 1] = gt1;
                            a_e[lr * 2] = ea; a_e[lr * 2 + 1] = eb;
                            a_lr[lr * 2] = __hip_atomic_fetch_add(&hist[ea], 1, __ATOMIC_RELAXED, __HIP_MEMORY_SCOPE_WORKGROUP);
                            a_lr[lr * 2 + 1] = __hip_atomic_fetch_add(&hist[eb], 1, __ATOMIC_RELAXED, __HIP_MEMORY_SCOPE_WORKGROUP);
                        }
                    }
                }
                __syncthreads();
                if (tid < NE) basee[tid] = (int)atomicAdd(&gcnt[tid], (unsigned)hist[tid]);
                __syncthreads();
                if (tid < 128) { const int e_ = a_e[tid], rk = basee[e_] + a_lr[tid]; rank[chunk * 128 + tid] = rk; etok[e_ * T + rk] = chunk * 64 + (tid >> 1); }
            }
        }
        SEAM(pb + 3);
        if (IN(pb + 5) || IN(pb + 6)) {
            PH_BEGIN WS_PTRS
            LAS int* tstart = (LAS int*)(ldx + LX_TSTART);
            __syncthreads();
            if (tid == 0) { int s = 0; for (int e = 0; e < NE; ++e) { tstart[e] = s; s += ((int)gcnt[e] + 255) / 256; } tstart[NE] = s; }
            if (tid < NE) ((LAS int*)(ldx + LX_CNT))[tid] = (int)gcnt[tid];
            __syncthreads();
        }
        if (IN(pb + 5)) REP_(9) {
            PH_BEGIN WS_PTRS
            pg8::Gemm g{H, W1 + (size_t)l * NE * 1024 * DM, NSLOT, NE * 1024, DM}; MoeOrder S{(const LAS int*)(ldx + LX_TSTART), G, bx, (const LAS int*)(ldx + LX_CNT), etok};
            EpiGUm E{HDN};
            pg8::gemm_phase_g<EpiGUm, MoeOrder, true, true>(lds, g, S, E);
        }
        SEAM(pb + 5);
        if (IN(pb + 6)) REP_(10) {
            PH_BEGIN WS_PTRS
            pg8::Gemm g{HDN, W2 + (size_t)l * NE * DM * DE, NSLOT, NE * 1024, DE}; MoeOrder S{(const LAS int*)(ldx + LX_TSTART), G, bx, (const LAS int*)(ldx + LX_CNT), etok};
            EpiYm E{Y};
            pg8::gemm_phase<EpiYm, MoeOrder, true, true>(lds, g, S, E);
        }
        SEAM(pb + 6);
        if (IN(pb + 7)) REP_(11) {
            PH_BEGIN WS_PTRS
            const bool last = (l + 1 == DEPTH);
            LAS int* tstart = (LAS int*)(ldx + LX_TSTART);
            __syncthreads();
            if (tid == 0) { int s = 0; for (int e = 0; e < NE; ++e) { tstart[e] = s; s += ((int)gcnt[e] + 255) / 256; } tstart[NE] = s; }
            __syncthreads();
            const float* gnext = last ? ka->in[20] : ka->in[4] + (l + 1) * DM; const float* mnext = mod + (size_t)(l + 1) * BATCH * 6144;
            for (int row = gw; row < T; row += NGW) {
                const int b = row >> 11;
                f32x4 v[4], y0[4], y1[4]; load_row(X1 + (size_t)row * DM, lane, v);
                const int s0 = tstart[eid[row * 2]] * 256 + rank[row * 2], s1 = tstart[eid[row * 2 + 1]] * 256 + rank[row * 2 + 1];
                load_row_bf16(Y + (size_t)s0 * DM, lane, y0); load_row_bf16(Y + (size_t)s1 * DM, lane, y1);
                const float g0 = gate[row * 2], g1 = gate[row * 2 + 1];
                const float* gt2 = modl + (size_t)b * 6144 + 5 * 1024;
#pragma unroll
                for (int j = 0; j < 4; ++j) { const f32x4 gg = *(const f32x4*)(gt2 + 256 * j + 4 * lane); v[j] = v[j] + gg * (y0[j] * g0 + y1[j] * g1); }
                if (last) { norm_mod_row(v, gnext, nullptr, nullptr, lane); store_row_f32(ka->out + (size_t)row * DM, lane, v); }
                else { store_row_f32(X2 + (size_t)row * DM, lane, v);
                    const float* m = mnext + (size_t)b * 6144; norm_mod_row(v, gnext, m + 1024, m, lane); store_row_bf16(H + (size_t)row * DM, lane, v); }
            }
        }
        SEAM(pb + 7);
    }
#undef IN
#undef SEAM
}

extern "C" void kernel_launch(void* const* d_in, const int* in_sizes, int n_in, void* d_out, int out_size, void* d_ws, size_t ws_size, hipStream_t stream) {
    static int grid = 0;
    if (grid == 0) {
        if (n_in != 21 || ws_size < WS_END || out_size != T * DM) { fprintf(stderr, "kernel_launch: unexpected shapes (n_in %d, ws %zu, out %d)\n", n_in, ws_size, out_size); grid = -1; return; }
        int dev = 0, cus = 0;
        if (hipGetDevice(&dev) != hipSuccess || hipDeviceGetAttribute(&cus, hipDeviceAttributeMultiprocessorCount, dev) != hipSuccess) { grid = -1; return; }
        if (hipFuncSetAttribute((const void*)mk_fwd, hipFuncAttributeMaxDynamicSharedMemorySize, LDS_BYTES) != hipSuccess) { fprintf(stderr, "kernel_launch: hipFuncSetAttribute failed\n"); grid = -1; return; }
        int per_cu = 0;
        if (hipOccupancyMaxActiveBlocksPerMultiprocessor(&per_cu, (const void*)mk_fwd, NTHREADS, LDS_BYTES) != hipSuccess || per_cu < 1) { fprintf(stderr, "kernel_launch: occupancy query says %d\n", per_cu); }
        (void)hipGetLastError();
        grid = cus;
    }
    if (grid < 0) return;
    const float* lambda_ = (const float*)d_in[7]; const float* subln = (const float*)d_in[8]; const float* na_rpb = (const float*)d_in[9];
    const float* conv_dw = (const float*)d_in[10]; const float* conv_b = (const float*)d_in[11]; const float* conv_g = (const float*)d_in[12]; const float* conv_bn = (const float*)d_in[13];
    (void)lambda_;
    unsigned char* ws = (unsigned char*)d_ws;
    float* lamv = (float*)(ws + OFF_LAM); bf16_t* P = (bf16_t*)(ws + OFF_P); bf16_t* CC = (bf16_t*)(ws + OFF_C);
    (void)hipMemsetAsync(ws + OFF_CTL, 0, CTL_BYTES, stream);
    Args a{};
    for (int i = 0; i < 21; ++i) a.in[i] = (const float*)d_in[i];
    a.out = (float*)d_out; a.ws = ws;
    auto run = [&](int lo, int hi) { a.ph_lo = lo; a.ph_hi = hi; hipLaunchKernelGGL(mk_fwd, dim3(grid), dim3(NTHREADS), LDS_BYTES, stream, a); };
    run(0, NPH);
}
```
